# Optimizing an MI355X kernel written in HIP

```python
import math
import jax, jax.numpy as jnp
from jax import lax
import numpy as np

D_MODEL = 1024
BATCH = 32
SEQ = 256
DEPTH = 4
DEC_BATCH = 2
DEC_SEQ = 2048
PAST_LEN = 512

GRID_W = 64
N_BRANCH = 4
BRANCH_W = D_MODEL // 2
SSM_GROUP = 16
SSM_GROUPS = BRANCH_W // SSM_GROUP
SSM_STATE = 64
FFT_GROUPS = 4
FFT_GW = BRANCH_W // FFT_GROUPS
MLA_HEADS = 8
NOPE_DIM = 64
ROPE_DIM = 32
V_DIM = BRANCH_W // MLA_HEADS
QK_DIM = NOPE_DIM + ROPE_DIM
Q_RANK = 3 * D_MODEL // 8
KV_RANK = D_MODEL // 4
ROPE_THETA = 10000.0
CONV_W = 3
D_FF = -(-8 * D_MODEL // (3 * 256)) * 256
Q_BLOCK = 128
EPS = 1e-6

OFF_SSM = 0
OFF_FFT = OFF_SSM + BRANCH_W
OFF_CQ = OFF_FFT + BRANCH_W
OFF_CKV = OFF_CQ + Q_RANK
OFF_KPE = OFF_CKV + KV_RANK
OFF_CONV = OFF_KPE + ROPE_DIM
IN_COLS = OFF_CONV + 3 * BRANCH_W

kernel_name = 'hybrid_diffusion_trunk_step'


def rms_norm(x, g):
    xf = x.astype(jnp.float32)
    y = xf * lax.rsqrt(jnp.mean(xf * xf, axis=-1, keepdims=True) + EPS)
    return (y * g.astype(jnp.float32)).astype(x.dtype)


def modulation(cond, w_ada, b_ada):
    m = jax.nn.silu(cond) @ w_ada + b_ada
    return jnp.split(m[:, None, :], 6, axis=-1)


def axial_rope(n_tok):
    rows = n_tok // GRID_W
    row = jnp.repeat(jnp.arange(rows, dtype=jnp.float32), GRID_W)
    col = jnp.tile(jnp.arange(GRID_W, dtype=jnp.float32), rows)
    n_freq = ROPE_DIM // 4
    inv = ROPE_THETA ** (-jnp.arange(n_freq, dtype=jnp.float32) / n_freq)
    ang = jnp.concatenate([row[:, None] * inv, col[:, None] * inv], axis=-1)
    return jnp.cos(ang), jnp.sin(ang)


def apply_rope(x, cos, sin):
    xf = x.astype(jnp.float32).reshape(x.shape[:-1] + (ROPE_DIM // 2, 2))
    xe, xo = xf[..., 0], xf[..., 1]
    c, s = cos[:, None, :], sin[:, None, :]
    out = jnp.stack([xe * c - xo * s, xe * s + xo * c], axis=-1)
    return out.reshape(x.shape).astype(x.dtype)


def attention(q, k, v):
    b, lq, h, dk = q.shape
    nb = lq // Q_BLOCK
    qb = q.reshape(b, nb, Q_BLOCK, h, dk).transpose(1, 0, 2, 3, 4)
    scale = dk ** -0.5

    def one_block(qblk):
        s = jnp.einsum('bqhd,bkhd->bhqk', qblk, k).astype(jnp.float32) * scale
        p = jax.nn.softmax(s, axis=-1).astype(v.dtype)
        return jnp.einsum('bhqk,bkhd->bqhd', p, v)

    o = lax.map(one_block, qb)
    return o.transpose(1, 0, 2, 3, 4).reshape(b, lq, h, v.shape[-1])


def mla_queries(c_q, q_a_norm_g, w_uq, q_norm_g, rope_cs):
    b, l, _ = c_q.shape
    q = (rms_norm(c_q, q_a_norm_g) @ w_uq).reshape(b, l, MLA_HEADS, QK_DIM)
    q = rms_norm(q, q_norm_g)
    if rope_cs is not None:
        q = jnp.concatenate([q[..., :NOPE_DIM], apply_rope(q[..., NOPE_DIM:], *rope_cs)], axis=-1)
    return q


def mla_keys_values(ckv_n, k_pe, w_ukv, k_norm_g, rope_cs):
    b, l, _ = ckv_n.shape
    kv = (ckv_n @ w_ukv).reshape(b, l, MLA_HEADS, NOPE_DIM + V_DIM)
    k_nope, v = kv[..., :NOPE_DIM], kv[..., NOPE_DIM:]
    k_rot = jnp.broadcast_to(k_pe[:, :, None, :], (b, l, MLA_HEADS, ROPE_DIM)).astype(k_nope.dtype)
    k = rms_norm(jnp.concatenate([k_nope, k_rot], axis=-1), k_norm_g)
    if rope_cs is not None:
        k = jnp.concatenate([k[..., :NOPE_DIM], apply_rope(k[..., NOPE_DIM:], *rope_cs)], axis=-1)
    return k, v


def _cplx_affine_combine(e1, e2):
    a1r, a1i, b1r, b1i = e1
    a2r, a2i, b2r, b2i = e2
    return (a2r * a1r - a2i * a1i,
            a2r * a1i + a2i * a1r,
            a2r * b1r - a2i * b1i + b2r,
            a2r * b1i + a2i * b1r + b2i)


def ssm_scan(uf, h0, lam_re, lam_im, log_dt, b_re, b_im, c_re, c_im, reverse):
    f32 = jnp.float32
    lam_re, lam_im = lam_re.astype(f32), lam_im.astype(f32)
    dt = jnp.exp(log_dt.astype(f32))[:, None]
    mag = jnp.exp(lam_re * dt)
    a_re, a_im = mag * jnp.cos(lam_im * dt), mag * jnp.sin(lam_im * dt)
    den = lam_re * lam_re + lam_im * lam_im
    f_re = ((a_re - 1.0) * lam_re + a_im * lam_im) / den
    f_im = (a_im * lam_re - (a_re - 1.0) * lam_im) / den
    b_re, b_im = b_re.astype(f32), b_im.astype(f32)
    bb_re = f_re[..., None] * b_re - f_im[..., None] * b_im
    bb_im = f_re[..., None] * b_im + f_im[..., None] * b_re
    x_re = jnp.einsum('blgc,gpc->blgp', uf, bb_re)
    x_im = jnp.einsum('blgc,gpc->blgp', uf, bb_im)
    a_re_t = jnp.broadcast_to(a_re, x_re.shape)
    a_im_t = jnp.broadcast_to(a_im, x_re.shape)
    acc_re, acc_im, h_re, h_im = lax.associative_scan(
        _cplx_affine_combine, (a_re_t, a_im_t, x_re, x_im), axis=1, reverse=reverse)
    if h0 is not None:
        s_re, s_im = h0[..., 0][:, None], h0[..., 1][:, None]
        h_re, h_im = (h_re + acc_re * s_re - acc_im * s_im,
                      h_im + acc_re * s_im + acc_im * s_re)
    y = (jnp.einsum('blgp,gcp->blgc', h_re, c_re.astype(f32))
         - jnp.einsum('blgp,gcp->blgc', h_im, c_im.astype(f32)))
    end = 0 if reverse else -1
    final = jnp.stack([h_re[:, end], h_im[:, end]], axis=-1)
    return y, final


def s5_branch(u, h0, lam_re, lam_im, log_dt, b_re, b_im, c_re, c_im, d_skip, w_glu):
    b, l, _ = u.shape
    uf = u.astype(jnp.float32).reshape(b, l, SSM_GROUPS, SSM_GROUP)
    ys, finals = [], []
    for d, rev in ((0, False), (1, True)):
        init = None if h0 is None else h0[:, d].astype(jnp.float32)
        y_d, h_d = ssm_scan(uf, init, lam_re[d], lam_im[d], log_dt[d], b_re[d], b_im[d],
                            c_re[d], c_im[d], rev)
        ys.append(y_d)
        finals.append(h_d)
    y = ys[0] + ys[1] + uf * d_skip.astype(jnp.float32).reshape(SSM_GROUPS, SSM_GROUP)
    y = jax.nn.gelu(y.reshape(b, l, BRANCH_W)).astype(u.dtype)
    y = y * jax.nn.sigmoid(y @ w_glu)
    return y, jnp.stack(finals, axis=1).astype(u.dtype)


def fourier_branch(u):
    b, l, _ = u.shape
    ug = u.astype(jnp.float32).reshape(b, l, FFT_GROUPS, FFT_GW)
    f = jnp.fft.fft2(ug, axes=(1, 3), norm='ortho')
    return jnp.real(f).reshape(b, l, BRANCH_W).astype(u.dtype)


def short_conv(z, conv_w):
    rhs = conv_w[:, None, :].astype(z.dtype)
    return lax.conv_general_dilated(z, rhs, window_strides=(1,), padding=((1, 1),),
                                    dimension_numbers=('NWC', 'WIO', 'NWC'),
                                    feature_group_count=z.shape[-1])


def mixer(xn, lp, ctx, rope_cs):
    b, l, _ = xn.shape
    z = xn @ lp['w_in']
    u_ssm = z[..., OFF_SSM:OFF_SSM + BRANCH_W]
    u_fft = z[..., OFF_FFT:OFF_FFT + BRANCH_W]
    c_q = z[..., OFF_CQ:OFF_CQ + Q_RANK]
    c_kv = z[..., OFF_CKV:OFF_CKV + KV_RANK]
    k_pe = z[..., OFF_KPE:OFF_KPE + ROPE_DIM]
    h_in = z[..., OFF_CONV:OFF_CONV + BRANCH_W]
    g_b = z[..., OFF_CONV + BRANCH_W:OFF_CONV + 2 * BRANCH_W]
    g_c = z[..., OFF_CONV + 2 * BRANCH_W:OFF_CONV + 3 * BRANCH_W]

    ckv_n = rms_norm(c_kv, lp['kv_a_norm_g'])
    q = mla_queries(c_q, lp['q_a_norm_g'], lp['w_uq'], lp['q_norm_g'], rope_cs)
    k, v = mla_keys_values(ckv_n, k_pe, lp['w_ukv'], lp['k_norm_g'], rope_cs)
    if ctx is None:
        h0 = None
    else:
        ckv_ctx, kpe_ctx, h0 = ctx
        k_c, v_c = mla_keys_values(ckv_ctx, kpe_ctx, lp['w_ukv'], lp['k_norm_g'], None)
        k = jnp.concatenate([k, k_c.astype(k.dtype)], axis=1)
        v = jnp.concatenate([v, v_c.astype(v.dtype)], axis=1)
    y_attn = attention(q, k, v).reshape(b, l, MLA_HEADS * V_DIM)

    y_ssm, ssm_final = s5_branch(u_ssm, h0, lp['ssm_lam_re'], lp['ssm_lam_im'], lp['ssm_log_dt'],
                                 lp['ssm_b_re'], lp['ssm_b_im'], lp['ssm_c_re'], lp['ssm_c_im'],
                                 lp['ssm_d'], lp['w_glu'])
    y_fft = fourier_branch(u_fft)
    y_conv = g_b * short_conv(g_c * h_in, lp['conv_w'])

    branches = jnp.stack([y_ssm, y_fft, y_attn.astype(y_ssm.dtype), y_conv], axis=2)
    proj = jnp.einsum('blkw,kwd->blkd', branches, lp['w_branch'])
    gates = jax.nn.sigmoid(xn @ lp['w_gate'] + lp['b_gate']).reshape(b, l, N_BRANCH, D_MODEL)
    out = jnp.sum(gates * proj, axis=2) @ lp['w_out']
    return out, ckv_n, k_pe, ssm_final


def swiglu(xn, w_ffn_in, w_ffn_out):
    gu = xn @ w_ffn_in
    g, u = gu[..., :D_FF], gu[..., D_FF:]
    return (jax.nn.silu(g) * u) @ w_ffn_out


def layer(x, cond, lp, ctx, rope_cs):
    sh_m, sc_m, g_m, sh_f, sc_f, g_f = modulation(cond, lp['w_ada'], lp['b_ada'])
    xn = rms_norm(x, lp['norm_mix_g']) * (1 + sc_m) + sh_m
    mix, ckv_n, k_pe, ssm_final = mixer(xn, lp, ctx, rope_cs)
    x = x + g_m * mix
    xn = rms_norm(x, lp['norm_ffn_g']) * (1 + sc_f) + sh_f
    x = x + g_f * swiglu(xn, lp['w_ffn_in'], lp['w_ffn_out'])
    return x, ckv_n, k_pe, ssm_final


def setup_inputs(seed: int = 0) -> dict:
    key = jax.random.key(seed)
    ks = iter(jax.random.split(key, 48))
    f32 = jnp.float32

    def nrm(shape, scale):
        return jax.random.normal(next(ks), shape, f32) * scale

    n_idx = jnp.arange(SSM_STATE, dtype=f32)
    sdir = (DEPTH, 2, SSM_GROUPS)
    return {
        'x_prompt': nrm((BATCH, SEQ, D_MODEL), 1.0),
        'x_sample': nrm((DEC_BATCH, DEC_SEQ, D_MODEL), 1.0),
        'cache_ckv': nrm((DEC_BATCH, DEPTH, PAST_LEN, KV_RANK), 1.0),
        'cache_kpe': nrm((DEC_BATCH, DEPTH, PAST_LEN, ROPE_DIM), 1.0),
        'state_ssm': nrm((DEC_BATCH, DEPTH, 2, SSM_GROUPS, SSM_STATE, 2), 0.1),
        'c': nrm((DEC_BATCH, D_MODEL), 1.0),
        'c_ctx': nrm((D_MODEL,), 1.0),
        'norm_mix_g': 1.0 + nrm((DEPTH, D_MODEL), 0.02),
        'norm_ffn_g': 1.0 + nrm((DEPTH, D_MODEL), 0.02),
        'w_ada': nrm((DEPTH, D_MODEL, 6 * D_MODEL), 0.5 * D_MODEL ** -0.5),
        'b_ada': nrm((DEPTH, 6 * D_MODEL), 0.01),
        'w_in': nrm((DEPTH, D_MODEL, IN_COLS), D_MODEL ** -0.5),
        'q_a_norm_g': 1.0 + nrm((DEPTH, Q_RANK), 0.02),
        'kv_a_norm_g': 1.0 + nrm((DEPTH, KV_RANK), 0.02),
        'w_uq': nrm((DEPTH, Q_RANK, MLA_HEADS * QK_DIM), Q_RANK ** -0.5),
        'w_ukv': nrm((DEPTH, KV_RANK, MLA_HEADS * (NOPE_DIM + V_DIM)), KV_RANK ** -0.5),
        'q_norm_g': 1.0 + nrm((DEPTH, QK_DIM), 0.02),
        'k_norm_g': 1.0 + nrm((DEPTH, QK_DIM), 0.02),
        'ssm_lam_re': -0.5 + nrm(sdir + (SSM_STATE,), 0.01),
        'ssm_lam_im': jnp.pi * n_idx + nrm(sdir + (SSM_STATE,), 0.01),
        'ssm_log_dt': jax.random.uniform(next(ks), sdir, f32, math.log(1e-3), math.log(1e-1)),
        'ssm_b_re': nrm(sdir + (SSM_STATE, SSM_GROUP), (2 * SSM_GROUP) ** -0.5),
        'ssm_b_im': nrm(sdir + (SSM_STATE, SSM_GROUP), (2 * SSM_GROUP) ** -0.5),
        'ssm_c_re': nrm(sdir + (SSM_GROUP, SSM_STATE), (2 * SSM_STATE) ** -0.5 * 4.0),
        'ssm_c_im': nrm(sdir + (SSM_GROUP, SSM_STATE), (2 * SSM_STATE) ** -0.5 * 4.0),
        'ssm_d': nrm((DEPTH, BRANCH_W), 1.0),
        'w_glu': nrm((DEPTH, BRANCH_W, BRANCH_W), BRANCH_W ** -0.5),
        'conv_w': nrm((DEPTH, CONV_W, BRANCH_W), CONV_W ** -0.5),
        'w_branch': nrm((DEPTH, N_BRANCH, BRANCH_W, D_MODEL), BRANCH_W ** -0.5),
        'w_gate': nrm((DEPTH, D_MODEL, N_BRANCH * D_MODEL), D_MODEL ** -0.5),
        'b_gate': nrm((DEPTH, N_BRANCH * D_MODEL), 0.01),
        'w_out': nrm((DEPTH, D_MODEL, D_MODEL), D_MODEL ** -0.5),
        'w_ffn_in': nrm((DEPTH, D_MODEL, 2 * D_FF), D_MODEL ** -0.5),
        'w_ffn_out': nrm((DEPTH, D_FF, D_MODEL), D_FF ** -0.5),
    }


def reference(x_prompt, x_sample, cache_ckv, cache_kpe, state_ssm, c, c_ctx,
              norm_mix_g, norm_ffn_g, w_ada, b_ada, w_in, q_a_norm_g, kv_a_norm_g,
              w_uq, w_ukv, q_norm_g, k_norm_g, ssm_lam_re, ssm_lam_im, ssm_log_dt,
              ssm_b_re, ssm_b_im, ssm_c_re, ssm_c_im, ssm_d, w_glu, conv_w,
              w_branch, w_gate, b_gate, w_out, w_ffn_in, w_ffn_out):
    rope_cs = axial_rope(x_sample.shape[1])
    cond_ctx = c_ctx[None, :]
    y_p, y_s = x_prompt, x_sample
    ckv_list, kpe_list, ssm_list = [], [], []
    for l in range(DEPTH):
        lp = {
            'norm_mix_g': norm_mix_g[l], 'norm_ffn_g': norm_ffn_g[l],
            'w_ada': w_ada[l], 'b_ada': b_ada[l], 'w_in': w_in[l],
            'q_a_norm_g': q_a_norm_g[l], 'kv_a_norm_g': kv_a_norm_g[l],
            'w_uq': w_uq[l], 'w_ukv': w_ukv[l], 'q_norm_g': q_norm_g[l], 'k_norm_g': k_norm_g[l],
            'ssm_lam_re': ssm_lam_re[l], 'ssm_lam_im': ssm_lam_im[l], 'ssm_log_dt': ssm_log_dt[l],
            'ssm_b_re': ssm_b_re[l], 'ssm_b_im': ssm_b_im[l],
            'ssm_c_re': ssm_c_re[l], 'ssm_c_im': ssm_c_im[l],
            'ssm_d': ssm_d[l], 'w_glu': w_glu[l], 'conv_w': conv_w[l],
            'w_branch': w_branch[l], 'w_gate': w_gate[l], 'b_gate': b_gate[l], 'w_out': w_out[l],
            'w_ffn_in': w_ffn_in[l], 'w_ffn_out': w_ffn_out[l],
        }
        y_p, ckv_n, k_pe, ssm_final = layer(y_p, cond_ctx, lp, None, None)
        ckv_list.append(ckv_n)
        kpe_list.append(k_pe)
        ssm_list.append(ssm_final)
        y_s, _, _, _ = layer(y_s, c, lp, (cache_ckv[:, l], cache_kpe[:, l], state_ssm[:, l]), rope_cs)
    new_ckv = jnp.stack(ckv_list, axis=1)
    new_kpe = jnp.stack(kpe_list, axis=1)
    new_ssm = jnp.stack(ssm_list, axis=1)
    return (y_p, y_s, new_ckv, new_kpe, new_ssm)
```

```cpp
#include <hip/hip_runtime.h>
#include <hip/hip_cooperative_groups.h>
#include <cstdio>
#include <cstdint>
namespace cg = cooperative_groups;

#define DI __device__ __forceinline__
#define LAS __attribute__((address_space(3)))
typedef unsigned short bf16_t;
typedef short bf16x8 __attribute__((ext_vector_type(8)));
typedef float f32x4 __attribute__((ext_vector_type(4)));
typedef float f32x2 __attribute__((ext_vector_type(2)));
typedef float f32x16 __attribute__((ext_vector_type(16)));
typedef unsigned u32x4 __attribute__((ext_vector_type(4)));
typedef unsigned u32x2 __attribute__((ext_vector_type(2)));
typedef __bf16 bf16x2_t __attribute__((ext_vector_type(2)));

#ifndef N_LAUNCH_MODE
#define N_LAUNCH_MODE 0
#endif

constexpr int DM = 1024, NCTX = 8192, NLAT = 4096, MTOK = 12288, MKV = 13312, NLAYER = 4;
constexpr int ZLD = 3328, NG1 = 7424, DFF = 2816;
constexpr int OFF_FFT = 512, OFF_CQ = 1024, OFF_CKV = 1408, OFF_KPE = 1664, OFF_HIN = 1696, OFF_GB = 2208, OFF_GC = 2720;
constexpr float EPS = 1e-6f;
constexpr int NTHREADS = 512, NWAVES = 8;
constexpr int LDS_BYTES = 131072 + 16;

constexpr size_t al256(size_t x) { return (x + 255) & ~(size_t)255; }
constexpr size_t WT_G1 = 0;
constexpr size_t WT_UQ = WT_G1 + (size_t)NG1 * 1024 * 2;
constexpr size_t WT_UKN = WT_UQ + (size_t)768 * 384 * 2;
constexpr size_t WT_UV = WT_UKN + (size_t)512 * 256 * 2;
constexpr size_t WT_GLU = WT_UV + (size_t)512 * 256 * 2;
constexpr size_t WT_BR = WT_GLU + (size_t)512 * 512 * 2;
constexpr size_t WT_OUT = WT_BR + (size_t)4 * 1024 * 512 * 2;
constexpr size_t WT_FIN = WT_OUT + (size_t)1024 * 1024 * 2;
constexpr size_t WT_FOUT = WT_FIN + (size_t)5632 * 1024 * 2;
constexpr size_t WS_Z = al256(WT_FOUT + (size_t)1024 * 2816 * 2);
constexpr size_t WS_GATES = WS_Z + (size_t)MTOK * ZLD * 2;
constexpr size_t WS_XN = WS_GATES + (size_t)MTOK * 4096 * 2;
constexpr size_t WS_CQN = WS_XN + (size_t)MTOK * 1024 * 2;
constexpr size_t WS_CKVN = WS_CQN + (size_t)MTOK * 384 * 2;
constexpr size_t WS_QRAW = WS_CKVN + (size_t)MKV * 256 * 2;
constexpr size_t WS_KNOPE = WS_QRAW + (size_t)MTOK * 768 * 2;
constexpr size_t WS_VT = WS_KNOPE + (size_t)MKV * 512 * 2;
constexpr size_t WS_K = WS_VT + (size_t)512 * MKV * 2;
constexpr size_t WS_PQT = WS_K + (size_t)MKV * 768 * 2;
constexpr size_t PQT_LAT_EL = (size_t)512 * 16384;
constexpr size_t WS_BR = WS_PQT + (size_t)512 * 24576 * 2;
constexpr size_t WS_YPRE = WS_CQN;
constexpr size_t WS_X = WS_BR + (size_t)4 * MTOK * 512 * 2;
constexpr size_t WS_DCH = WS_X + (size_t)MTOK * 1024 * 4;
constexpr size_t WS_DCTX = WS_DCH + (size_t)1024 * 512 * 2;
constexpr size_t WS_DLAT = WS_DCTX + (size_t)256 * 512 * 2;
constexpr size_t WS_MOD = WS_DLAT + (size_t)2048 * 4096 * 2;
constexpr size_t WS_ROPE = al256(WS_MOD + (size_t)4 * 3 * 6144 * 4);
constexpr size_t WS_SSMA = WS_ROPE + (size_t)2048 * 32 * 4;
constexpr size_t WS_BBC = WS_SSMA + (size_t)256 * 64 * 4 * 4;
constexpr size_t WS_CCAT = WS_BBC + (size_t)256 * 128 * 16 * 2;
constexpr size_t WS_CST = WS_CCAT + (size_t)256 * 16 * 128 * 2;
constexpr size_t WS_BAR = WS_CST + (size_t)2 * 2 * 32 * 8 * 128 * 4;
constexpr size_t WS_FT = WS_BAR + 16384;
constexpr size_t WS_END = WS_FT + (size_t)NLAT * 512 * 2;

constexpr size_t OUT_CKV = (size_t)MTOK * 1024, OUT_KPE = OUT_CKV + (size_t)32 * 4 * 256 * 256, OUT_SSM = OUT_KPE + (size_t)32 * 4 * 256 * 32;

DI unsigned pk2(float a, float b) { f32x2 v = {a, b}; bf16x2_t r = __builtin_convertvector(v, bf16x2_t); return __builtin_bit_cast(unsigned, r); }
DI float bflo(unsigned u) { return __uint_as_float(u << 16); }
DI float bfhi(unsigned u) { return __uint_as_float(u & 0xffff0000u); }
DI float sigmoidf_(float x) { return __builtin_amdgcn_rcpf(1.f + __builtin_amdgcn_exp2f(-1.44269504f * x)); }
DI float siluf_(float x) { return x * sigmoidf_(x); }
DI float geluf_(float x) { const float y = 0.7978845608f * (x + 0.044715f * x * x * x); return x * sigmoidf_(2.f * y); }
DI float wave_sum(float v) {
#pragma unroll
    for (int o = 1; o < 64; o <<= 1) v += __shfl_xor(v, o);
    return v;
}
DI void keep(const bf16x8& v) { asm volatile("" :: "v"(v)); }
DI void opaque16(f32x16& v) { asm volatile("" : "+v"(v)); }
DI void opaque4(f32x4& v) { asm volatile("" : "+v"(v)); }
DI float xmax32(float v) { const unsigned uu = __float_as_uint(v); const u32x2 r = __builtin_amdgcn_permlane32_swap(uu, uu, false, false); return fmaxf(__uint_as_float(r[0]), __uint_as_float(r[1])); }
DI int cond_of(int r) { return r < NCTX ? 0 : 1 + ((r - NCTX) >> 11); }

namespace pg8 {
constexpr int BM = 256, BK = 64, HALF = 128, HTB = HALF * BK * 2, STAGE_BYTES = 8 * HTB, NXCD = 8, WGM = 8;
DI int lds_byte(int r, int c) { const int st = (r >> 4) * 2 + (c >> 5), rr = r & 15, cc = c & 31, ob = rr * 64 + cc * 2; return st * 1024 + (ob ^ (((ob >> 9) & 1) << 5)); }
DI void stage_rc(int b, int& R, int& C) { const int st = b / 1024, sb = b % 1024, swz = sb ^ (((sb >> 9) & 1) << 5); R = (st >> 1) * 16 + swz / 64; C = (st & 1) * 32 + (swz % 64) / 2; }
DI int perm32(int rho) { const int n = rho >> 4, i = rho & 15; return 8 * (i >> 2) + 4 * n + (i & 3); }

struct Unit { int pm, pn, z; };
struct Sched {
    const char* A; const char* B; size_t azs, bzs;
    int lda, ldb, K, nM, nN, nZ, kind, G, c;
    DI bool next(int i, Unit& u) const {
        const int nwg = nM * nN;
        if (kind == 2) {
            const long L = (long)(i / nZ) * G + c; if (L >= nwg) return false;
            u.z = i % nZ; u.pm = (int)L / nN; u.pn = (int)L % nN; return true;
        }
        const long L = (long)i * G + c;
        if (kind == 1) { if (L >= (long)nwg * nZ) return false; u.z = (int)(L / nwg); const int r = (int)(L % nwg); u.pm = r / nN; u.pn = r % nN; return true; }
        if (L >= nwg) return false;
        int wgid = (int)L; { const int q = nwg / NXCD, r = nwg % NXCD, xcd = wgid % NXCD, off = wgid / NXCD; wgid = (xcd < r ? xcd * (q + 1) : r * (q + 1) + (xcd - r) * q) + off; }
        const int nig = WGM * nN, gid = wgid / nig, fm = gid * WGM, gsz = (nM - fm) < WGM ? (nM - fm) : WGM;
        u.pm = fm + ((wgid % nig) % gsz); u.pn = (wgid % nig) / gsz; u.z = 0; return true;
    }
    DI const char* aptr(const Unit& u) const { return A + (size_t)u.z * azs + (size_t)u.pm * (size_t)(BM * 2) * lda; }
    DI const char* bptr(const Unit& u) const { return B + (size_t)u.z * bzs + (size_t)u.pn * (size_t)(BM * 2) * ldb; }
};

template <class Epi>
DI void gemm_phase(LAS unsigned char* lds, const Sched& S, const Epi& E) {
    int tid = threadIdx.x; asm volatile("" : "+v"(tid));
    const int wid = __builtin_amdgcn_readfirstlane(tid >> 6), lane = tid & 63, wr = wid >> 2, wc = wid & 3, fr = lane & 15, fq = lane >> 4;
    const int K = S.K, nt = K / BK;
    unsigned voffA[2], voffB[2];
#pragma unroll
    for (int i = 0; i < 2; ++i) { int R, C; stage_rc(tid * 16 + i * 8192, R, C); const int Rb = E.perm ? ((R & ~31) + perm32(R & 31)) : R;
        voffA[i] = (unsigned)(R * S.lda + C) * 2u; voffB[i] = (unsigned)(Rb * S.ldb + C) * 2u; }
    const size_t kstep = (size_t)(BK * 2);
    const size_t hstepA = (size_t)HALF * S.lda * 2, hstepB = (size_t)HALF * S.ldb * 2;
    const unsigned ldsw = (unsigned)wid * 1024u;
    const int aoff = lds_byte(wr * 64 + fr, fq * 8), boff = lds_byte(wc * 32 + fr, fq * 8);
#define PG8_SA(b, h) (((b) * 2 + (h)) * HTB)
#define PG8_SB(b, h) ((4 + (b) * 2 + (h)) * HTB)
#define PG8_STAGE(bufoff, gbase, voff) do { _Pragma("unroll") for (int _i = 0; _i < 2; ++_i) \
        __builtin_amdgcn_global_load_lds((const unsigned*)((const char*)(gbase) + (voff)[_i]), (LAS unsigned*)(lds + (bufoff) + ldsw + _i * 8192), 16, 0, 0); } while (0)
#define PG8_LDA(dst, b, h) do { _Pragma("unroll") for (int m = 0; m < 4; ++m) _Pragma("unroll") for (int k = 0; k < 2; ++k) dst[m][k] = *(const LAS bf16x8*)(lds + PG8_SA(b, h) + aoff + m * 2048 + k * 1024); } while (0)
#define PG8_LDB(dst, b, h) do { _Pragma("unroll") for (int n = 0; n < 2; ++n) _Pragma("unroll") for (int k = 0; k < 2; ++k) dst[n][k] = *(const LAS bf16x8*)(lds + PG8_SB(b, h) + boff + n * 2048 + k * 1024); } while (0)
#define PG8_MMA(ai, bj, At, Bt) do { __builtin_amdgcn_s_setprio(1); _Pragma("unroll") for (int m = 0; m < 4; ++m) _Pragma("unroll") for (int n = 0; n < 2; ++n) _Pragma("unroll") for (int k = 0; k < 2; ++k) \
        acc[ai][bj][m][n] = __builtin_amdgcn_mfma_f32_16x16x32_bf16(Bt[n][k], At[m][k], acc[ai][bj][m][n], 0, 0, 0); __builtin_amdgcn_s_setprio(0); } while (0)
#define PG8_WAIT_V(n) asm volatile("s_waitcnt vmcnt(" #n ")" ::: "memory")
#define PG8_WAIT_L(n) asm volatile("s_waitcnt lgkmcnt(" #n ")" ::: "memory")
#define PG8_BAR __builtin_amdgcn_s_barrier()
#define PG8_SCHED __builtin_amdgcn_sched_barrier(0)
    Unit cur, nxt; int ui = 0;
    if (!S.next(0, cur)) return;
    f32x4 acc[2][2][4][2];
#pragma unroll
    for (int a = 0; a < 2; ++a)
#pragma unroll
        for (int b = 0; b < 2; ++b)
#pragma unroll
            for (int m = 0; m < 4; ++m)
#pragma unroll
                for (int n = 0; n < 2; ++n) acc[a][b][m][n] = (f32x4){0.f, 0.f, 0.f, 0.f};
    bf16x8 At[4][2], B0[2][2], B1[2][2];
    const char* cA = S.aptr(cur); const char* cB = S.bptr(cur);
    PG8_STAGE(PG8_SB(0, 0), cB, voffB); PG8_STAGE(PG8_SA(0, 0), cA, voffA); PG8_STAGE(PG8_SB(0, 1), cB + hstepB, voffB); PG8_STAGE(PG8_SA(0, 1), cA + hstepA, voffA);
    if (wr == 1) PG8_BAR;
    PG8_WAIT_V(4); PG8_BAR;
    PG8_STAGE(PG8_SB(1, 0), cB + kstep, voffB); PG8_STAGE(PG8_SA(1, 0), cA + kstep, voffA); PG8_STAGE(PG8_SB(1, 1), cB + hstepB + kstep, voffB);
    PG8_WAIT_V(6); PG8_BAR;
    for (;;) {
        const bool has_next = S.next(ui + 1, nxt);
        const char* nA = has_next ? S.aptr(nxt) : cA; const char* nB = has_next ? S.bptr(nxt) : cB;
        for (int t = 0; t < nt; t += 2) {
            const bool last = (t == nt - 2);
            const char* a1 = cA + (size_t)(t + 1) * kstep;
            const char* a2 = last ? nA : cA + (size_t)(t + 2) * kstep; const char* b2 = last ? nB : cB + (size_t)(t + 2) * kstep;
            const char* a3 = a2 + kstep; const char* b3 = b2 + kstep;
            PG8_LDB(B0, 0, 0); PG8_SCHED; PG8_LDA(At, 0, 0); PG8_STAGE(PG8_SA(1, 1), a1 + hstepA, voffA);
            PG8_WAIT_L(8); PG8_BAR; PG8_WAIT_L(0); PG8_MMA(0, 0, At, B0); PG8_BAR; PG8_SCHED;
            PG8_LDB(B1, 0, 1); PG8_STAGE(PG8_SB(0, 0), b2, voffB);
            PG8_BAR; PG8_WAIT_L(0); PG8_MMA(0, 1, At, B1); PG8_BAR;
            PG8_LDA(At, 0, 1); PG8_STAGE(PG8_SA(0, 0), a2, voffA);
            PG8_BAR; PG8_WAIT_L(0); PG8_MMA(1, 0, At, B0); PG8_BAR; PG8_SCHED;
            PG8_STAGE(PG8_SB(0, 1), b2 + hstepB, voffB);
            PG8_WAIT_V(6); PG8_BAR; PG8_MMA(1, 1, At, B1); PG8_BAR;
            PG8_LDB(B0, 1, 0); PG8_SCHED; PG8_LDA(At, 1, 0); PG8_STAGE(PG8_SA(0, 1), a2 + hstepA, voffA);
            PG8_WAIT_L(8); PG8_BAR; PG8_WAIT_L(0); PG8_MMA(0, 0, At, B0); PG8_BAR; PG8_SCHED;
            PG8_LDB(B1, 1, 1); PG8_STAGE(PG8_SB(1, 0), b3, voffB);
            PG8_BAR; PG8_WAIT_L(0); PG8_MMA(0, 1, At, B1); PG8_BAR;
            PG8_LDA(At, 1, 1); PG8_STAGE(PG8_SA(1, 0), a3, voffA);
            PG8_BAR; PG8_WAIT_L(0); PG8_MMA(1, 0, At, B0); PG8_BAR; PG8_SCHED;
            PG8_STAGE(PG8_SB(1, 1), b3 + hstepB, voffB);
            PG8_WAIT_V(6); PG8_BAR; PG8_MMA(1, 1, At, B1); PG8_BAR;
        }
        E(acc, cur, wr, wc, fr, fq);
        if (!has_next) break;
#pragma unroll
        for (int a = 0; a < 2; ++a)
#pragma unroll
            for (int b = 0; b < 2; ++b)
#pragma unroll
                for (int m = 0; m < 4; ++m)
#pragma unroll
                    for (int n = 0; n < 2; ++n) acc[a][b][m][n] = (f32x4){0.f, 0.f, 0.f, 0.f};
        cur = nxt; cA = nA; cB = nB; ++ui;
    }
    PG8_WAIT_V(0);
    if (wr == 0) PG8_BAR;
    PG8_BAR;
#undef PG8_SA
#undef PG8_SB
#undef PG8_STAGE
#undef PG8_LDA
#undef PG8_LDB
#undef PG8_MMA
#undef PG8_WAIT_V
#undef PG8_WAIT_L
#undef PG8_BAR
#undef PG8_SCHED
}
}

enum { M_BF16 = 0, M_G1 = 1, M_FFT1 = 2, M_GLU = 3, M_SWIGLU = 4, M_RES = 5, M_BRANCH = 6 };
struct Epi {
    int mode, perm, ldc; size_t zstride;
    void* O; void* O2; const void* X0; const void* X1;
    DI void operator()(const f32x4 (&acc)[2][2][4][2], const pg8::Unit& u, int wr, int wc, int fr, int fq) const {
        const int row0 = u.pm * 256 + wr * 64 + fr;
        if (mode == M_SWIGLU) {
#pragma unroll
            for (int ai = 0; ai < 2; ++ai)
#pragma unroll
                for (int m = 0; m < 4; ++m) {
                    const int r = row0 + ai * 128 + m * 16;
                    const f32x4 g0 = acc[ai][0][m][0], g1 = acc[ai][0][m][1], u0 = acc[ai][1][m][0], u1 = acc[ai][1][m][1];
                    u32x4 o; o.x = pk2(siluf_(g0[0]) * u0[0], siluf_(g0[1]) * u0[1]); o.y = pk2(siluf_(g0[2]) * u0[2], siluf_(g0[3]) * u0[3]);
                    o.z = pk2(siluf_(g1[0]) * u1[0], siluf_(g1[1]) * u1[1]); o.w = pk2(siluf_(g1[2]) * u1[2], siluf_(g1[3]) * u1[3]);
                    *(u32x4*)((bf16_t*)O + (size_t)r * DFF + u.pn * 128 + wc * 32 + 8 * fq) = o;
                }
            return;
        }
        if (mode == M_RES) {
            const int col0 = u.pn * 256 + wc * 32 + 4 * fq;
            const float* gvp = (const float*)O2 + cond_of(row0) * 6144 + col0;
            f32x4 gv[2][2];
#pragma unroll
            for (int bj = 0; bj < 2; ++bj)
#pragma unroll
                for (int n = 0; n < 2; ++n) gv[bj][n] = *(const f32x4*)(gvp + bj * 128 + n * 16);
            const float* xbase = row0 < NCTX ? (const float*)X0 + (size_t)row0 * 1024 : (const float*)X1 + (size_t)(row0 - NCTX) * 1024;
#pragma unroll
            for (int ai = 0; ai < 2; ++ai)
#pragma unroll
                for (int mh = 0; mh < 2; ++mh) {
                    f32x4 xo[2][2][2];
#pragma unroll
                    for (int mm = 0; mm < 2; ++mm)
#pragma unroll
                        for (int bj = 0; bj < 2; ++bj)
#pragma unroll
                            for (int n = 0; n < 2; ++n) xo[mm][bj][n] = *(const f32x4*)(xbase + (size_t)(ai * 128 + (2 * mh + mm) * 16) * 1024 + col0 + bj * 128 + n * 16);
#pragma unroll
                    for (int mm = 0; mm < 2; ++mm)
#pragma unroll
                        for (int bj = 0; bj < 2; ++bj)
#pragma unroll
                            for (int n = 0; n < 2; ++n) { const int r = row0 + ai * 128 + (2 * mh + mm) * 16, c = col0 + bj * 128 + n * 16;
                                *(f32x4*)((float*)O + (size_t)r * 1024 + c) = xo[mm][bj][n] + gv[bj][n] * acc[ai][bj][2 * mh + mm][n]; }
                }
            return;
        }
        if (mode == M_BRANCH) {
            const int col0 = u.pn * 256 + wc * 32 + 8 * fq, k = u.z, ftid = (wr * 4 + wc) * 64 + fq * 16 + fr;
#pragma unroll
            for (int ai = 0; ai < 2; ++ai) {
                u32x4 gt[4][2], mv[4][2];
#pragma unroll
                for (int m = 0; m < 4; ++m)
#pragma unroll
                    for (int bj = 0; bj < 2; ++bj) {
                        gt[m][bj] = *(const u32x4*)((const bf16_t*)X0 + ((size_t)((u.pm * 16 + 4 * k + u.pn) * 16 + ai * 8 + m * 2 + bj) * 512 + ftid) * 8);
                        if (k > 0) mv[m][bj] = *(const u32x4*)((const bf16_t*)O + ((size_t)((u.pm * 4 + u.pn) * 16 + ai * 8 + m * 2 + bj) * 512 + ftid) * 8); }
#pragma unroll
                for (int m = 0; m < 4; ++m)
#pragma unroll
                    for (int bj = 0; bj < 2; ++bj) { const int r = row0 + ai * 128 + m * 16, c = col0 + bj * 128;
                        const u32x4 g4 = gt[m][bj]; f32x4 v0 = acc[ai][bj][m][0], v1 = acc[ai][bj][m][1];
                        v0[0] *= bflo(g4.x); v0[1] *= bfhi(g4.x); v0[2] *= bflo(g4.y); v0[3] *= bfhi(g4.y);
                        v1[0] *= bflo(g4.z); v1[1] *= bfhi(g4.z); v1[2] *= bflo(g4.w); v1[3] *= bfhi(g4.w);
                        if (k > 0) { const u32x4 p4 = mv[m][bj];
                            v0[0] += bflo(p4.x); v0[1] += bfhi(p4.x); v0[2] += bflo(p4.y); v0[3] += bfhi(p4.y);
                            v1[0] += bflo(p4.z); v1[1] += bfhi(p4.z); v1[2] += bflo(p4.w); v1[3] += bfhi(p4.w); }
                        u32x4 o; o.x = pk2(v0[0], v0[1]); o.y = pk2(v0[2], v0[3]); o.z = pk2(v1[0], v1[1]); o.w = pk2(v1[2], v1[3]);
                        if (k < 3) *(u32x4*)((bf16_t*)O + ((size_t)((u.pm * 4 + u.pn) * 16 + ai * 8 + m * 2 + bj) * 512 + ftid) * 8) = o;
                        else *(u32x4*)((bf16_t*)O2 + (size_t)r * 1024 + c) = o; }
            }
            return;
        }
        if (mode == M_GLU) {
            const int col0 = u.pn * 256 + wc * 32 + 8 * fq;
#pragma unroll
            for (int ai = 0; ai < 2; ++ai) {
                u32x4 yv[4][2];
#pragma unroll
                for (int m = 0; m < 4; ++m)
#pragma unroll
                    for (int bj = 0; bj < 2; ++bj) yv[m][bj] = *(const u32x4*)((const bf16_t*)X0 + (size_t)(row0 + ai * 128 + m * 16) * 512 + col0 + bj * 128);
#pragma unroll
                for (int m = 0; m < 4; ++m)
#pragma unroll
                    for (int bj = 0; bj < 2; ++bj) { const u32x4 y = yv[m][bj]; const f32x4 v0 = acc[ai][bj][m][0], v1 = acc[ai][bj][m][1];
                        u32x4 o; o.x = pk2(bflo(y.x) * sigmoidf_(v0[0]), bfhi(y.x) * sigmoidf_(v0[1])); o.y = pk2(bflo(y.y) * sigmoidf_(v0[2]), bfhi(y.y) * sigmoidf_(v0[3]));
                        o.z = pk2(bflo(y.z) * sigmoidf_(v1[0]), bfhi(y.z) * sigmoidf_(v1[1])); o.w = pk2(bflo(y.w) * sigmoidf_(v1[2]), bfhi(y.w) * sigmoidf_(v1[3]));
                        *(u32x4*)((bf16_t*)O + (size_t)(row0 + ai * 128 + m * 16) * 512 + col0 + bj * 128) = o; }
            }
            return;
        }
        if (mode == M_G1 && u.pn >= 13) {
            const int cc0 = u.pn * 256 + wc * 32 + 8 * fq - ZLD;
            f32x4 bb[2][2];
#pragma unroll
            for (int bj = 0; bj < 2; ++bj) { bb[bj][0] = *(const f32x4*)((const float*)X0 + cc0 + bj * 128); bb[bj][1] = *(const f32x4*)((const float*)X0 + cc0 + bj * 128 + 4); }
#pragma unroll
            for (int ai = 0; ai < 2; ++ai)
#pragma unroll
                for (int m = 0; m < 4; ++m)
#pragma unroll
                    for (int bj = 0; bj < 2; ++bj) { const f32x4 v0 = acc[ai][bj][m][0] + bb[bj][0], v1 = acc[ai][bj][m][1] + bb[bj][1];
                        u32x4 o; o.x = pk2(sigmoidf_(v0[0]), sigmoidf_(v0[1])); o.y = pk2(sigmoidf_(v0[2]), sigmoidf_(v0[3])); o.z = pk2(sigmoidf_(v1[0]), sigmoidf_(v1[1])); o.w = pk2(sigmoidf_(v1[2]), sigmoidf_(v1[3]));
                        *(u32x4*)((bf16_t*)O2 + ((size_t)((u.pm * 16 + (u.pn - 13)) * 16 + ai * 8 + m * 2 + bj) * 512 + (wr * 4 + wc) * 64 + fq * 16 + fr) * 8) = o; }
            return;
        }
        const int col0 = u.pn * 256 + wc * 32 + 8 * fq;
#pragma unroll
        for (int ai = 0; ai < 2; ++ai)
#pragma unroll
            for (int m = 0; m < 4; ++m) {
                const int r = row0 + ai * 128 + m * 16;
#pragma unroll
                for (int bj = 0; bj < 2; ++bj) {
                    const int c = col0 + bj * 128;
                    f32x4 v0 = acc[ai][bj][m][0], v1 = acc[ai][bj][m][1];
                    bf16_t* dst;
                    if (mode == M_BF16) { dst = (bf16_t*)O + (size_t)u.z * zstride + (size_t)r * ldc + c; }
                    else if (mode == M_G1) { dst = (bf16_t*)O + (size_t)r * ZLD + c; }
                    else {
                        const int g = r >> 8, pq = (r >> 7) & 1, mm = r & 127, nidx = g * 128 + mm;
                        if (c < NCTX) dst = (bf16_t*)O + (size_t)nidx * 16384 + (c >> 8) * 512 + pq * 256 + (c & 255);
                        else { const int t = c - NCTX; dst = (bf16_t*)O + PQT_LAT_EL + (size_t)nidx * 8192 + (t >> 11) * 4096 + pq * 2048 + (t & 2047); }
                    }
                    u32x4 o; o.x = pk2(v0[0], v0[1]); o.y = pk2(v0[2], v0[3]); o.z = pk2(v1[0], v1[1]); o.w = pk2(v1[2], v1[3]);
                    *(u32x4*)dst = o;
                }
            }
    }
};

struct Args { const float* in[34]; float* out; unsigned char* ws; int ph_lo, ph_hi; };
struct Ctx {
    const float* const* in; float* out; unsigned char* ws; LAS unsigned char* lds;
    int tid, lane, wave, G, bid, gw, NGW;
};
#define WSP(T, off) ((T*)(C.ws + (off)))

DI void transpose_item(const float* W, int N, bf16_t* WTrow0  , int ldt, int k0, int n0, LAS float* scr, int lane) {
#pragma unroll 8
    for (int i = 0; i < 32; ++i) { const int kk = 2 * i + (lane >> 5); scr[kk * 33 + (lane & 31)] = W[(size_t)(k0 + kk) * N + n0 + (lane & 31)]; }
    const int c = lane & 7;
#pragma unroll
    for (int j = 0; j < 4; ++j) { const int n = (lane >> 3) + 8 * j; const LAS float* s = scr + (8 * c) * 33 + n;
        u32x4 o; o.x = pk2(s[0], s[33]); o.y = pk2(s[2 * 33], s[3 * 33]); o.z = pk2(s[4 * 33], s[5 * 33]); o.w = pk2(s[6 * 33], s[7 * 33]);
        *(u32x4*)(WTrow0 + (size_t)n * ldt + k0 + 8 * c) = o; }
}
DI void convert_weights(const Ctx& C, int layer, int it_lo, int it_hi, int gw, int ngw) {
    LAS float* scr = (LAS float*)(C.lds + C.wave * 8704);
    constexpr int I_IN = 16 * 101, I_GATE = 16 * 128, I_UQ = 6 * 24, I_UKV = 4 * 32, I_GLU = 8 * 16, I_BR = 4 * 8 * 32, I_OUT = 16 * 32, I_FIN = 16 * 176, I_FOUT = 44 * 32;
    constexpr int NITEMS = I_IN + I_GATE + I_UQ + I_UKV + I_GLU + I_BR + I_OUT + I_FIN + I_FOUT;
    (void)NITEMS;
    for (int it = it_lo + gw; it < it_hi; it += ngw) {
        int r = it;
        if (r < I_IN) { const int nb = 101, kb = r / nb, n0 = 32 * (r % nb); transpose_item(C.in[11] + (size_t)layer * 1024 * 3232, 3232, WSP(bf16_t, WT_G1) + (size_t)n0 * 1024, 1024, 64 * kb, n0, scr, C.lane); continue; } r -= I_IN;
        if (r < I_GATE) { const int nb = 128, kb = r / nb, n0 = 32 * (r % nb); transpose_item(C.in[29] + (size_t)layer * 1024 * 4096, 4096, WSP(bf16_t, WT_G1) + (size_t)(ZLD + n0) * 1024, 1024, 64 * kb, n0, scr, C.lane); continue; } r -= I_GATE;
        if (r < I_UQ) { const int nb = 24, kb = r / nb, n0 = 32 * (r % nb); transpose_item(C.in[14] + (size_t)layer * 384 * 768, 768, WSP(bf16_t, WT_UQ) + (size_t)n0 * 384, 384, 64 * kb, n0, scr, C.lane); continue; } r -= I_UQ;
        if (r < I_UKV) { const int nb = 32, kb = r / nb, n0 = 32 * (r % nb); const int h = n0 >> 7, j0 = n0 & 127;
            bf16_t* dst = (j0 < 64) ? WSP(bf16_t, WT_UKN) + (size_t)(h * 64 + j0) * 256 : WSP(bf16_t, WT_UV) + (size_t)(h * 64 + j0 - 64) * 256;
            transpose_item(C.in[15] + (size_t)layer * 256 * 1024, 1024, dst, 256, 64 * kb, n0, scr, C.lane); continue; } r -= I_UKV;
        if (r < I_GLU) { const int nb = 16, kb = r / nb, n0 = 32 * (r % nb); transpose_item(C.in[26] + (size_t)layer * 512 * 512, 512, WSP(bf16_t, WT_GLU) + (size_t)n0 * 512, 512, 64 * kb, n0, scr, C.lane); continue; } r -= I_GLU;
        if (r < I_BR) { const int k = r / 256, rr = r % 256, nb = 32, kb = rr / nb, n0 = 32 * (rr % nb);
            transpose_item(C.in[28] + ((size_t)layer * 4 + k) * 512 * 1024, 1024, WSP(bf16_t, WT_BR) + ((size_t)k * 1024 + n0) * 512, 512, 64 * kb, n0, scr, C.lane); continue; } r -= I_BR;
        if (r < I_OUT) { const int nb = 32, kb = r / nb, n0 = 32 * (r % nb); transpose_item(C.in[31] + (size_t)layer * 1024 * 1024, 1024, WSP(bf16_t, WT_OUT) + (size_t)n0 * 1024, 1024, 64 * kb, n0, scr, C.lane); continue; } r -= I_OUT;
        if (r < I_FIN) { const int nb = 176, kb = r / nb, n0 = 32 * (r % nb);
            const int drow = (n0 < DFF) ? (n0 >> 7) * 256 + (n0 & 127) : ((n0 - DFF) >> 7) * 256 + 128 + ((n0 - DFF) & 127);
            transpose_item(C.in[32] + (size_t)layer * 1024 * 5632, 5632, WSP(bf16_t, WT_FIN) + (size_t)drow * 1024, 1024, 64 * kb, n0, scr, C.lane); continue; } r -= I_FIN;
        { const int nb = 32, kb = r / nb, n0 = 32 * (r % nb); transpose_item(C.in[33] + (size_t)layer * DFF * 1024, 1024, WSP(bf16_t, WT_FOUT) + (size_t)n0 * DFF, DFF, 64 * kb, n0, scr, C.lane); }
    }
}

constexpr int CW_G1_END = 16 * 101 + 16 * 128, CW_GLU_END = CW_G1_END + 6 * 24 + 4 * 32 + 8 * 16, CW_BR_END = CW_GLU_END + 4 * 8 * 32, CW_FIN_END = CW_BR_END + 16 * 32 + 16 * 176, CW_ALL = CW_FIN_END + 44 * 32;
DI void norm_rows(const Ctx& C, int layer, bool first, int which  ) {
    const float* gam = C.in[which ? 8 : 7] + layer * 1024;
    const float* mod = WSP(float, WS_MOD) + (size_t)layer * 3 * 6144;
    bf16_t* xn = WSP(bf16_t, WS_XN);
    for (int r = C.gw; r < MTOK; r += C.NGW) {
        const float* xr = first ? (r < NCTX ? C.in[0] + (size_t)r * 1024 : C.in[1] + (size_t)(r - NCTX) * 1024) : WSP(float, WS_X) + (size_t)r * 1024;
        const float* mv = mod + cond_of(r) * 6144 + which * 3072;
        f32x4 v[4], gg[4], shh[4], scc[4]; float ss = 0.f;
#pragma unroll
        for (int j = 0; j < 4; ++j) { const int c = 4 * C.lane + 256 * j; v[j] = *(const f32x4*)(xr + c); gg[j] = *(const f32x4*)(gam + c); shh[j] = *(const f32x4*)(mv + c); scc[j] = *(const f32x4*)(mv + 1024 + c); }
#pragma unroll
        for (int j = 0; j < 4; ++j) ss += v[j][0] * v[j][0] + v[j][1] * v[j][1] + v[j][2] * v[j][2] + v[j][3] * v[j][3];
        const float rinv = __builtin_amdgcn_rsqf(wave_sum(ss) * (1.f / 1024.f) + EPS);
#pragma unroll
        for (int j = 0; j < 4; ++j) { const int c = 4 * C.lane + 256 * j;
            const f32x4 g = gg[j], sh = shh[j], sc = scc[j];
            f32x4 o;
#pragma unroll
            for (int e = 0; e < 4; ++e) o[e] = v[j][e] * rinv * g[e] * (1.f + sc[e]) + sh[e];
            u32x2 p; p.x = pk2(o[0], o[1]); p.y = pk2(o[2], o[3]); *(u32x2*)(xn + (size_t)r * 1024 + c) = p; }
    }
}

DI void phase0(const Ctx& C) {
    for (int i = C.bid * NTHREADS + C.tid; i < 96 * 1024 / 8; i += C.G * NTHREADS) *(u32x4*)(WSP(bf16_t, WT_G1) + (size_t)3232 * 1024 + (size_t)i * 8) = (u32x4){0u, 0u, 0u, 0u};
    LAS float* sc = (LAS float*)C.lds; LAS float* red = sc + 3072;
    for (int i = C.tid; i < 3072; i += NTHREADS) { const int cd = i >> 10, k = i & 1023; const float v = cd == 0 ? C.in[6][k] : C.in[5][(cd - 1) * 1024 + k]; sc[i] = siluf_(v); }
    __syncthreads();
    for (int job = C.bid; job < 384; job += C.G) {
        const int l = job / 96, col0 = (job % 96) * 64;
        const float* W = C.in[9] + (size_t)l * 1024 * 6144 + col0 + C.lane;
        float a0 = 0.f, a1 = 0.f, a2 = 0.f;
#pragma unroll 8
        for (int kk = 0; kk < 128; ++kk) { const int k = C.wave * 128 + kk; const float w = W[(size_t)k * 6144]; a0 += sc[k] * w; a1 += sc[1024 + k] * w; a2 += sc[2048 + k] * w; }
        red[(C.wave * 3 + 0) * 64 + C.lane] = a0; red[(C.wave * 3 + 1) * 64 + C.lane] = a1; red[(C.wave * 3 + 2) * 64 + C.lane] = a2;
        __syncthreads();
        if (C.wave < 3) { float s = 0.f;
#pragma unroll
            for (int w = 0; w < 8; ++w) s += red[(w * 3 + C.wave) * 64 + C.lane];
            WSP(float, WS_MOD)[((size_t)l * 3 + C.wave) * 6144 + col0 + C.lane] = s + C.in[10][l * 6144 + col0 + C.lane]; }
        __syncthreads();
    }
    const int gt = C.bid * NTHREADS + C.tid, NT = C.G * NTHREADS;
    for (int e = gt; e < 16384; e += NT) {
        const int ldg = e >> 6, p = e & 63;
        const float lr = C.in[18][e], li = C.in[19][e], dt = expf(C.in[20][ldg]);
        const float mag = expf(lr * dt), ar = mag * cosf(li * dt), ai = mag * sinf(li * dt);
        float pr = ar, pi = ai;
#pragma unroll
        for (int s = 0; s < 8; ++s) { const float nr = pr * pr - pi * pi, ni = 2.f * pr * pi; pr = nr; pi = ni; }
        *(f32x4*)(WSP(float, WS_SSMA) + (size_t)e * 4) = (f32x4){ar, ai, pr, pi};
        const float den = lr * lr + li * li;
        const float fr_ = ((ar - 1.f) * lr + ai * li) / den, fi_ = (ai * lr - (ar - 1.f) * li) / den;
        const float* bre = C.in[21] + (size_t)e * 16; const float* bim = C.in[22] + (size_t)e * 16;
        bf16_t* bbr = WSP(bf16_t, WS_BBC) + ((size_t)ldg * 128 + p) * 16; bf16_t* bbi = bbr + 64 * 16;
#pragma unroll
        for (int c = 0; c < 16; c += 2) {
            const float r0 = fr_ * bre[c] - fi_ * bim[c], i0 = fr_ * bim[c] + fi_ * bre[c], r1 = fr_ * bre[c + 1] - fi_ * bim[c + 1], i1 = fr_ * bim[c + 1] + fi_ * bre[c + 1];
            *(unsigned*)(bbr + c) = pk2(r0, r1); *(unsigned*)(bbi + c) = pk2(i0, i1);
        }
        const float* cre = C.in[23] + (size_t)ldg * 16 * 64; const float* cim = C.in[24] + (size_t)ldg * 16 * 64;
        bf16_t* cc = WSP(bf16_t, WS_CCAT) + (size_t)ldg * 16 * 128;
#pragma unroll
        for (int c = 0; c < 16; ++c) *(unsigned*)(cc + c * 128 + 2 * p) = pk2(cre[c * 64 + p], -cim[c * 64 + p]);
    }
    for (int e = gt; e < 2048 * 16; e += NT) {
        const int pos = e >> 4, i = e & 15; const float inv = exp2f(-(float)(i & 7) * (13.287712379549449f / 8.f));
        const float ang = (float)(i < 8 ? (pos >> 6) : (pos & 63)) * inv;
        *(f32x2*)(WSP(float, WS_ROPE) + (size_t)e * 2) = (f32x2){cosf(ang), sinf(ang)};
    }
    for (int ch = gt; ch < 1024 * 512 / 8; ch += NT) {
        const int r = ch >> 6, col0 = (ch & 63) * 8, g = r >> 8, pq = (r >> 7) & 1, m = r & 127; float v[8];
#pragma unroll
        for (int j = 0; j < 8; ++j) { const int col = col0 + j, c = col & 127; const float ph = (float)((m * c) & 127) * (1.f / 128.f);
            const float t = pq ? __builtin_amdgcn_sinf(ph) : __builtin_amdgcn_cosf(ph); v[j] = ((col >> 7) == g) ? t * 0.08838834764831845f : 0.f; }
        *(u32x4*)(WSP(bf16_t, WS_DCH) + (size_t)ch * 8) = (u32x4){pk2(v[0], v[1]), pk2(v[2], v[3]), pk2(v[4], v[5]), pk2(v[6], v[7])};
    }
    for (int ch = gt; ch < 256 * 512 / 8; ch += NT) {
        const int k = ch >> 6, l0 = (ch & 63) * 8; float v[8];
#pragma unroll
        for (int j = 0; j < 8; ++j) { const int lp = l0 + j, l = lp & 255; const float ph = (float)((k * l) & 255) * (1.f / 256.f);
            v[j] = (lp < 256 ? __builtin_amdgcn_cosf(ph) : -__builtin_amdgcn_sinf(ph)) * 0.0625f; }
        *(u32x4*)(WSP(bf16_t, WS_DCTX) + (size_t)ch * 8) = (u32x4){pk2(v[0], v[1]), pk2(v[2], v[3]), pk2(v[4], v[5]), pk2(v[6], v[7])};
    }
    for (int ch = gt; ch < 2048 * 4096 / 8; ch += NT) {
        const int k = ch >> 9, l0 = (ch & 511) * 8; float v[8];
#pragma unroll
        for (int j = 0; j < 8; ++j) { const int lp = l0 + j, l = lp & 2047; const float ph = (float)((k * l) & 2047) * (1.f / 2048.f);
            v[j] = (lp < 2048 ? __builtin_amdgcn_cosf(ph) : -__builtin_amdgcn_sinf(ph)) * 0.02209708691207961f; }
        *(u32x4*)(WSP(bf16_t, WS_DLAT) + (size_t)ch * 8) = (u32x4){pk2(v[0], v[1]), pk2(v[2], v[3]), pk2(v[4], v[5]), pk2(v[6], v[7])};
    }
}

DI void pc_rows(const Ctx& C, int layer) {
    const bf16_t* z = WSP(bf16_t, WS_Z);
    const float* qg = C.in[12] + layer * 384; const float* kvg = C.in[13] + layer * 256; const float* cw = C.in[27] + layer * 3 * 512;
    for (int r = C.gw; r < MKV; r += C.NGW) {
        if (r >= MTOK) {
            const int rr = r - MTOK, b = rr >> 9, pos = rr & 511;
            const f32x4 v = *(const f32x4*)(C.in[2] + (((size_t)b * 4 + layer) * 512 + pos) * 256 + 4 * C.lane);
            u32x2 o; o.x = pk2(v[0], v[1]); o.y = pk2(v[2], v[3]); *(u32x2*)(WSP(bf16_t, WS_CKVN) + (size_t)r * 256 + 4 * C.lane) = o; continue;
        }
        const bf16_t* zr = z + (size_t)r * ZLD;
        unsigned wq[3], wk[2], wkp = 0u; u32x4 ch1, cg1, cgb, ch0 = {0u, 0u, 0u, 0u}, cg0 = {0u, 0u, 0u, 0u}, ch2 = {0u, 0u, 0u, 0u}, cg2 = {0u, 0u, 0u, 0u};
        const int Lr = r < NCTX ? 256 : 2048, lr = r < NCTX ? (r & 255) : ((r - NCTX) & 2047);
        const bool hp = lr > 0, hn = lr < Lr - 1;
#pragma unroll
        for (int j = 0; j < 3; ++j) wq[j] = *(const unsigned*)(zr + OFF_CQ + 2 * C.lane + 128 * j);
#pragma unroll
        for (int j = 0; j < 2; ++j) wk[j] = *(const unsigned*)(zr + OFF_CKV + 2 * C.lane + 128 * j);
        if (r < NCTX && C.lane < 16) wkp = *(const unsigned*)(zr + OFF_KPE + 2 * C.lane);
        { const int c = 8 * C.lane;
            ch1 = *(const u32x4*)(zr + OFF_HIN + c); cg1 = *(const u32x4*)(zr + OFF_GC + c); cgb = *(const u32x4*)(zr + OFF_GB + c);
            if (hp) { ch0 = *(const u32x4*)(zr - ZLD + OFF_HIN + c); cg0 = *(const u32x4*)(zr - ZLD + OFF_GC + c); }
            if (hn) { ch2 = *(const u32x4*)(zr + ZLD + OFF_HIN + c); cg2 = *(const u32x4*)(zr + ZLD + OFF_GC + c); } }
        { unsigned w[3]; float ss = 0.f;
#pragma unroll
          for (int j = 0; j < 3; ++j) { w[j] = wq[j]; const float a = bflo(w[j]), b = bfhi(w[j]); ss += a * a + b * b; }
          const float rinv = __builtin_amdgcn_rsqf(wave_sum(ss) * (1.f / 384.f) + EPS);
#pragma unroll
          for (int j = 0; j < 3; ++j) { const int c = 2 * C.lane + 128 * j; *(unsigned*)(WSP(bf16_t, WS_CQN) + (size_t)r * 384 + c) = pk2(bflo(w[j]) * rinv * qg[c], bfhi(w[j]) * rinv * qg[c + 1]); } }
        { unsigned w[2]; float ss = 0.f;
#pragma unroll
          for (int j = 0; j < 2; ++j) { w[j] = wk[j]; const float a = bflo(w[j]), b = bfhi(w[j]); ss += a * a + b * b; }
          const float rinv = __builtin_amdgcn_rsqf(wave_sum(ss) * (1.f / 256.f) + EPS);
#pragma unroll
          for (int j = 0; j < 2; ++j) { const int c = 2 * C.lane + 128 * j; const float a = bflo(w[j]) * rinv * kvg[c], b = bfhi(w[j]) * rinv * kvg[c + 1];
              *(unsigned*)(WSP(bf16_t, WS_CKVN) + (size_t)r * 256 + c) = pk2(a, b);
              if (r < NCTX) { const int bb = r >> 8, l = r & 255; *(f32x2*)(C.out + OUT_CKV + (((size_t)bb * 4 + layer) * 256 + l) * 256 + c) = (f32x2){a, b}; } }
          if (r < NCTX && C.lane < 16) { const int bb = r >> 8, l = r & 255; const unsigned kp = wkp;
              *(f32x2*)(C.out + OUT_KPE + (((size_t)bb * 4 + layer) * 256 + l) * 32 + 2 * C.lane) = (f32x2){bflo(kp), bfhi(kp)}; } }
        { const int c0 = 8 * C.lane; unsigned ov[4];
#pragma unroll
          for (int j = 0; j < 4; ++j) { const int c = c0 + 2 * j;
              const unsigned h1 = ch1[j], g1 = cg1[j], gb = cgb[j], h0 = ch0[j], g0 = cg0[j], h2 = ch2[j], g2 = cg2[j];
              const float ya = cw[c] * bflo(h0) * bflo(g0) + cw[512 + c] * bflo(h1) * bflo(g1) + cw[1024 + c] * bflo(h2) * bflo(g2);
              const float yb = cw[c + 1] * bfhi(h0) * bfhi(g0) + cw[512 + c + 1] * bfhi(h1) * bfhi(g1) + cw[1024 + c + 1] * bfhi(h2) * bfhi(g2);
              ov[j] = pk2(bflo(gb) * ya, bfhi(gb) * yb); }
          *(u32x4*)(WSP(bf16_t, WS_BR) + ((size_t)3 * MTOK + r) * 512 + c0) = (u32x4){ov[0], ov[1], ov[2], ov[3]}; }
    }
}

template <bool WRITE_Y>
DI void ssm_job(const Ctx& C, int layer, int sb, int d, int g, int jc, LAS unsigned char* wl) {
    const int lane = C.lane, hh = lane >> 5, l31 = lane & 31;
    const int ldg = (layer * 2 + d) * 32 + g;
    const bool lat = sb >= 32;
    const int nchunk = lat ? 8 : 1, chunk = d == 0 ? jc : nchunk - 1 - jc;
    const int tok0 = lat ? NCTX + (sb - 32) * 2048 + chunk * 256 : sb * 256;
    const f32x4 av = *(const f32x4*)(WSP(float, WS_SSMA) + ((size_t)ldg * 64 + lane) * 4);
    const float ar = av[0], ai = av[1];
    float hr = 0.f, hi = 0.f;
    if (lat && WRITE_Y) {
        const float* h0 = C.in[4] + ((((size_t)(sb - 32) * 4 + layer) * 2 + d) * 32 + g) * 128 + lane * 2;
        hr = h0[0]; hi = h0[1];
        const float* cs = WSP(float, WS_CST) + ((((size_t)(sb - 32) * 2 + d) * 32 + g) * 8) * 128 + lane * 2;
        for (int j = 0; j < jc; ++j) { const float nr = av[2] * hr - av[3] * hi + cs[j * 128], ni = av[2] * hi + av[3] * hr + cs[j * 128 + 1]; hr = nr; hi = ni; }
    }
    bf16x8 BB[4];
#pragma unroll
    for (int nb = 0; nb < 4; ++nb) BB[nb] = *(const bf16x8*)(WSP(bf16_t, WS_BBC) + ((size_t)ldg * 128 + nb * 32 + l31) * 16 + 8 * hh);
    bf16x8 CC[4];
    if (WRITE_Y) {
#pragma unroll
        for (int kk = 0; kk < 4; ++kk) CC[kk] = *(const bf16x8*)(WSP(bf16_t, WS_CCAT) + ((size_t)ldg * 16 + (lane & 15)) * 128 + 32 * kk + 8 * (lane >> 4));
    }
    LAS float* Xl = (LAS float*)wl;
    LAS bf16_t* Hl = (LAS bf16_t*)(wl + 8192);
    const bf16_t* z = WSP(bf16_t, WS_Z);
    bf16_t* ydir = WSP(bf16_t, WS_XN) + (size_t)d * MTOK * 512;
    for (int i = 0; i < 8; ++i) {
        const int s = 32 * i + l31, tok = d == 0 ? tok0 + s : tok0 + 255 - s;
        const bf16x8 U = *(const bf16x8*)(z + (size_t)tok * ZLD + g * 16 + 8 * hh);
        f32x16 X[4];
#pragma unroll
        for (int nb = 0; nb < 4; ++nb) { f32x16 zz;
#pragma unroll
            for (int q = 0; q < 16; ++q) zz[q] = 0.f;
            opaque16(zz);
            X[nb] = __builtin_amdgcn_mfma_f32_32x32x16_bf16(U, BB[nb], zz, 0, 0, 0); }
        keep(U); keep(BB[0]); keep(BB[1]); keep(BB[2]); keep(BB[3]);
        asm volatile("s_nop 15\n\ts_nop 15\n\ts_nop 15\n\ts_nop 15" : "+v"(X[0]), "+v"(X[1]), "+v"(X[2]), "+v"(X[3]));
#pragma unroll
        for (int half = 0; half < 2; ++half) {
#pragma unroll
            for (int nb = 0; nb < 4; ++nb)
#pragma unroll
                for (int q = 0; q < 8; ++q) { const int mrow = (q & 3) + 8 * (q >> 2) + 4 * hh;
                    Xl[mrow * 128 + nb * 32 + l31] = X[nb][8 * half + q]; }
#pragma unroll 16
            for (int st = 0; st < 16; ++st) {
                const float xr = Xl[st * 128 + lane], xi = Xl[st * 128 + 64 + lane];
                const float nr = ar * hr - ai * hi + xr, ni = ar * hi + ai * hr + xi; hr = nr; hi = ni;
                if (WRITE_Y) *(LAS unsigned*)(Hl + st * 136 + 2 * lane) = pk2(hr, hi);
            }
            if (WRITE_Y) {
                f32x4 y = {0.f, 0.f, 0.f, 0.f}; opaque4(y);
#pragma unroll
                for (int kk = 0; kk < 4; ++kk) { const bf16x8 hb = *(const LAS bf16x8*)(Hl + (lane & 15) * 136 + 32 * kk + 8 * (lane >> 4));
                    y = __builtin_amdgcn_mfma_f32_16x16x32_bf16(CC[kk], hb, y, 0, 0, 0); keep(hb); keep(CC[kk]); }
                const int s2 = 32 * i + 16 * half + (lane & 15), tok2 = d == 0 ? tok0 + s2 : tok0 + 255 - s2;
                u32x2 o; o.x = pk2(y[0], y[1]); o.y = pk2(y[2], y[3]);
                *(u32x2*)(ydir + (size_t)tok2 * 512 + g * 16 + 4 * (lane >> 4)) = o;
            }
        }
    }
    if (!lat) *(f32x2*)(C.out + OUT_SSM + (((((size_t)sb * 4 + layer) * 2 + d) * 32 + g) * 64 + lane) * 2) = (f32x2){hr, hi};
    else if (!WRITE_Y) *(f32x2*)(WSP(float, WS_CST) + (((((size_t)(sb - 32) * 2 + d) * 32 + g) * 8 + jc) * 64 + lane) * 2) = (f32x2){hr, hi};
}
DI void ssm_phase_a(const Ctx& C, int layer) {
    LAS unsigned char* wl = C.lds + C.wave * 12800;
    for (int j = C.gw; j < 2048 + 896; j += C.NGW) {
        if (j < 2048) { const int sb = j >> 6, d = (j >> 5) & 1, g = j & 31; ssm_job<true>(C, layer, sb, d, g, 0, wl); }
        else { const int q = j - 2048, jc = q % 7, r = q / 7, sb = 32 + (r >> 6), d = (r >> 5) & 1, g = r & 31; ssm_job<false>(C, layer, sb, d, g, jc, wl); }
    }
}
DI void ssm_phase_b(const Ctx& C, int layer, int gw, int ngw) {
    LAS unsigned char* wl = C.lds + C.wave * 12800;
    for (int j = gw; j < 1024; j += ngw) { const int jc = j & 7, r = j >> 3, sb = 32 + (r >> 6), d = (r >> 5) & 1, g = r & 31; ssm_job<true>(C, layer, sb, d, g, jc, wl); }
}
DI void ssm_finish(const Ctx& C, int layer) {
    const bf16_t* y0 = WSP(bf16_t, WS_XN); const bf16_t* y1 = y0 + (size_t)MTOK * 512; const float* dsk = C.in[25] + layer * 512 + 8 * C.lane;
    const f32x4 d0 = *(const f32x4*)dsk, d1 = *(const f32x4*)(dsk + 4);
    for (int r = C.gw; r < MTOK; r += C.NGW) {
        const u32x4 a = *(const u32x4*)(y0 + (size_t)r * 512 + 8 * C.lane), b = *(const u32x4*)(y1 + (size_t)r * 512 + 8 * C.lane), u = *(const u32x4*)(WSP(bf16_t, WS_Z) + (size_t)r * ZLD + 8 * C.lane);
        u32x4 o;
        o.x = pk2(geluf_(bflo(a.x) + bflo(b.x) + bflo(u.x) * d0[0]), geluf_(bfhi(a.x) + bfhi(b.x) + bfhi(u.x) * d0[1]));
        o.y = pk2(geluf_(bflo(a.y) + bflo(b.y) + bflo(u.y) * d0[2]), geluf_(bfhi(a.y) + bfhi(b.y) + bfhi(u.y) * d0[3]));
        o.z = pk2(geluf_(bflo(a.z) + bflo(b.z) + bflo(u.z) * d1[0]), geluf_(bfhi(a.z) + bfhi(b.z) + bfhi(u.z) * d1[1]));
        o.w = pk2(geluf_(bflo(a.w) + bflo(b.w) + bflo(u.w) * d1[2]), geluf_(bfhi(a.w) + bfhi(b.w) + bfhi(u.w) * d1[3]));
        *(u32x4*)(WSP(bf16_t, WS_YPRE) + (size_t)r * 512 + 8 * C.lane) = o;
    }
}

DI void k_post(const Ctx& C, int layer) {
    const float* kg = C.in[17] + layer * 96; const int h = C.lane >> 3, sub = C.lane & 7;
    for (int r = C.gw; r < MKV; r += C.NGW) {
        const u32x4 kn = *(const u32x4*)(WSP(bf16_t, WS_KNOPE) + (size_t)r * 512 + h * 64 + 8 * sub);
        float e[4];
        if (r < MTOK) { const u32x2 kp = *(const u32x2*)(WSP(bf16_t, WS_Z) + (size_t)r * ZLD + OFF_KPE + 4 * sub); e[0] = bflo(kp.x); e[1] = bfhi(kp.x); e[2] = bflo(kp.y); e[3] = bfhi(kp.y); }
        else { const int rr = r - MTOK, b = rr >> 9, pos = rr & 511; const f32x4 kp = *(const f32x4*)(C.in[3] + (((size_t)b * 4 + layer) * 512 + pos) * 32 + 4 * sub); e[0] = kp[0]; e[1] = kp[1]; e[2] = kp[2]; e[3] = kp[3]; }
        const bool own = r >= NCTX && r < MTOK;
        f32x4 cs = {1.f, 0.f, 1.f, 0.f};
        if (own) cs = *(const f32x4*)(WSP(float, WS_ROPE) + ((size_t)((r - NCTX) & 2047) * 16 + 2 * sub) * 2);
        float v[8] = {bflo(kn.x), bfhi(kn.x), bflo(kn.y), bfhi(kn.y), bflo(kn.z), bfhi(kn.z), bflo(kn.w), bfhi(kn.w)};
        float ss = e[0] * e[0] + e[1] * e[1] + e[2] * e[2] + e[3] * e[3];
#pragma unroll
        for (int j = 0; j < 8; ++j) ss += v[j] * v[j];
        ss += __shfl_xor(ss, 1); ss += __shfl_xor(ss, 2); ss += __shfl_xor(ss, 4);
        const float rinv = __builtin_amdgcn_rsqf(ss * (1.f / 96.f) + EPS);
#pragma unroll
        for (int j = 0; j < 8; ++j) v[j] *= rinv * kg[8 * sub + j];
#pragma unroll
        for (int j = 0; j < 4; ++j) e[j] *= rinv * kg[64 + 4 * sub + j];
        if (own) {
            const float a0 = e[0] * cs[0] - e[1] * cs[1], b0 = e[0] * cs[1] + e[1] * cs[0], a1 = e[2] * cs[2] - e[3] * cs[3], b1 = e[2] * cs[3] + e[3] * cs[2];
            e[0] = a0; e[1] = b0; e[2] = a1; e[3] = b1; }
        bf16_t* kr = WSP(bf16_t, WS_K) + (size_t)r * 768 + h * 96;
        *(u32x4*)(kr + 8 * sub) = (u32x4){pk2(v[0], v[1]), pk2(v[2], v[3]), pk2(v[4], v[5]), pk2(v[6], v[7])};
        *(u32x2*)(kr + 64 + 4 * sub) = (u32x2){pk2(e[0], e[1]), pk2(e[2], e[3])};
    }
}

struct KVF { bf16x8 k[6]; bf16x8 v[2][2]; };
DI int attn_row0(bool lat, int b, int t) { return lat ? (t < 64 ? NCTX + b * 2048 + 32 * t : MTOK + b * 512 + 32 * (t - 64)) : b * 256 + 32 * t; }
DI void attn_load(const bf16_t* Kb, const bf16_t* Vb, int kr0, int l31, int hh, KVF& f) {
    const bf16_t* kp = Kb + (size_t)(kr0 + l31) * 768;
#pragma unroll
    for (int kk = 0; kk < 6; ++kk) f.k[kk] = *(const bf16x8*)(kp + 16 * kk);
#pragma unroll
    for (int db = 0; db < 2; ++db)
#pragma unroll
        for (int s = 0; s < 2; ++s) { const bf16_t* vp = Vb + (size_t)db * 32 * MKV + kr0 + 16 * s + 4 * hh;
            const u32x2 lo = *(const u32x2*)vp, hi2 = *(const u32x2*)(vp + 8); u32x4 w = {lo.x, lo.y, hi2.x, hi2.y}; f.v[db][s] = __builtin_bit_cast(bf16x8, w); }
}
DI void attn_tile(const KVF& f, const bf16x8 (&Q)[6], f32x16& O0, f32x16& O1, float& mrun, float& lrun) {
    f32x16 S;
#pragma unroll
    for (int q = 0; q < 16; ++q) S[q] = 0.f;
    opaque16(S);
#pragma unroll
    for (int kk = 0; kk < 6; ++kk) S = __builtin_amdgcn_mfma_f32_32x32x16_bf16(f.k[kk], Q[kk], S, 0, 0, 0);
    float mt = S[0];
#pragma unroll
    for (int q = 1; q < 16; ++q) mt = fmaxf(mt, S[q]);
    mt = xmax32(mt);
    const float mnew = fmaxf(mrun, mt), alpha = __builtin_amdgcn_exp2f(mrun - mnew); mrun = mnew;
    float ls = 0.f;
#pragma unroll
    for (int q = 0; q < 16; ++q) { S[q] = __builtin_amdgcn_exp2f(S[q] - mnew); ls += S[q]; }
    lrun = lrun * alpha + ls;
#pragma unroll
    for (int q = 0; q < 16; ++q) { O0[q] *= alpha; O1[q] *= alpha; }
#pragma unroll
    for (int s = 0; s < 2; ++s) { u32x4 p = {pk2(S[8 * s], S[8 * s + 1]), pk2(S[8 * s + 2], S[8 * s + 3]), pk2(S[8 * s + 4], S[8 * s + 5]), pk2(S[8 * s + 6], S[8 * s + 7])};
        const bf16x8 pf = __builtin_bit_cast(bf16x8, p);
        O0 = __builtin_amdgcn_mfma_f32_32x32x16_bf16(f.v[0][s], pf, O0, 0, 0, 0);
        O1 = __builtin_amdgcn_mfma_f32_32x32x16_bf16(f.v[1][s], pf, O1, 0, 0, 0); }
}
DI void attn_q(const Ctx& C, int layer, bool lat, int q0, int qt, int h, bf16x8 (&Q)[6]) {
    const int lane = C.lane, hh = lane >> 5, l31 = lane & 31;
    const float* qg = C.in[16] + layer * 96;
    const bf16_t* qr = WSP(bf16_t, WS_QRAW) + (size_t)(q0 + l31) * 768 + h * 96 + 8 * hh;
    float v[6][8]; float ss = 0.f;
#pragma unroll
    for (int kk = 0; kk < 6; ++kk) { const u32x4 w = *(const u32x4*)(qr + 16 * kk);
        v[kk][0] = bflo(w.x); v[kk][1] = bfhi(w.x); v[kk][2] = bflo(w.y); v[kk][3] = bfhi(w.y); v[kk][4] = bflo(w.z); v[kk][5] = bfhi(w.z); v[kk][6] = bflo(w.w); v[kk][7] = bfhi(w.w);
#pragma unroll
        for (int j = 0; j < 8; ++j) ss += v[kk][j] * v[kk][j]; }
    ss += __shfl_xor(ss, 32);
    const float rinv = __builtin_amdgcn_rsqf(ss * (1.f / 96.f) + EPS) * (0.10206207261596575f * 1.4426950408889634f);
#pragma unroll
    for (int kk = 0; kk < 6; ++kk)
#pragma unroll
        for (int j = 0; j < 8; ++j) v[kk][j] *= rinv * qg[16 * kk + 8 * hh + j];
    if (lat) { const int pos = qt * 32 + l31;
#pragma unroll
        for (int kk = 4; kk < 6; ++kk) { const float* cs = WSP(float, WS_ROPE) + ((size_t)pos * 16 + 8 * (kk - 4) + 4 * hh) * 2;
#pragma unroll
            for (int pr = 0; pr < 4; ++pr) { const float c = cs[2 * pr], s = cs[2 * pr + 1], xe = v[kk][2 * pr], xo = v[kk][2 * pr + 1]; v[kk][2 * pr] = xe * c - xo * s; v[kk][2 * pr + 1] = xe * s + xo * c; } } }
#pragma unroll
    for (int kk = 0; kk < 6; ++kk) { u32x4 p = {pk2(v[kk][0], v[kk][1]), pk2(v[kk][2], v[kk][3]), pk2(v[kk][4], v[kk][5]), pk2(v[kk][6], v[kk][7])}; Q[kk] = __builtin_bit_cast(bf16x8, p); }
}
constexpr int ATT_KB = 32 * 208, ATT_BUF = ATT_KB + 64 * 80, ATT_GRP = 2 * ATT_BUF, ATT_PART_OFF = 49152;
DI void attn_stage_load(const Ctx& C, bool lat, int b, int h, int t, int tg, u32x4 (&r)[3]) {
    const int kr0 = attn_row0(lat, b, t);
    { const int row = tg / 12, col = tg % 12; r[0] = *(const u32x4*)(WSP(bf16_t, WS_K) + (size_t)(kr0 + row) * 768 + h * 96 + col * 8); }
    if (tg < 128) { const int c = tg + 256, row = c / 12, col = c % 12; r[1] = *(const u32x4*)(WSP(bf16_t, WS_K) + (size_t)(kr0 + row) * 768 + h * 96 + col * 8); }
    { const int row = tg >> 2, col = tg & 3; r[2] = *(const u32x4*)(WSP(bf16_t, WS_VT) + (size_t)(h * 64 + row) * MKV + kr0 + col * 8); }
}
DI void attn_stage_store(LAS unsigned char* buf, int tg, const u32x4 (&r)[3]) {
    { const int row = tg / 12, col = tg % 12; *(LAS u32x4*)(buf + row * 208 + col * 16) = r[0]; }
    if (tg < 128) { const int c = tg + 256, row = c / 12, col = c % 12; *(LAS u32x4*)(buf + row * 208 + col * 16) = r[1]; }
    { const int row = tg >> 2, col = tg & 3; *(LAS u32x4*)(buf + ATT_KB + row * 80 + col * 16) = r[2]; }
}
DI void attn_frags(const LAS unsigned char* buf, int l31, int hh, KVF& f) {
#pragma unroll
    for (int kk = 0; kk < 6; ++kk) f.k[kk] = *(const LAS bf16x8*)(buf + l31 * 208 + 32 * kk + 16 * hh);
#pragma unroll
    for (int db = 0; db < 2; ++db)
#pragma unroll
        for (int s = 0; s < 2; ++s) { const LAS unsigned char* vp = buf + ATT_KB + (32 * db + l31) * 80 + 32 * s + 8 * hh;
            const u32x2 lo = *(const LAS u32x2*)vp, hi2 = *(const LAS u32x2*)(vp + 16); u32x4 w = {lo.x, lo.y, hi2.x, hi2.y}; f.v[db][s] = __builtin_bit_cast(bf16x8, w); }
}
DI void attn_run(const Ctx& C, bool lat, int b, int h, int t0, int nt, const bf16x8 (&Q)[6], f32x16& O0, f32x16& O1, float& mrun, float& lrun) {
    const int lane = C.lane, hh = lane >> 5, l31 = lane & 31, tg = C.tid & 255;
    LAS unsigned char* gbuf = C.lds + (C.wave >> 2) * ATT_GRP;
    u32x4 r[3];
    attn_stage_load(C, lat, b, h, t0, tg, r); attn_stage_store(gbuf, tg, r);
    __syncthreads();
    for (int i = 0; i < nt; ++i) {
        if (i + 1 < nt) attn_stage_load(C, lat, b, h, t0 + i + 1, tg, r);
        KVF f; attn_frags(gbuf + (i & 1) * ATT_BUF, l31, hh, f);
        attn_tile(f, Q, O0, O1, mrun, lrun);
        if (i + 1 < nt) attn_stage_store(gbuf + ((i + 1) & 1) * ATT_BUF, tg, r);
        __syncthreads();
    }
}
DI void attn_store(const Ctx& C, int q0, int h, const f32x16& O0, const f32x16& O1, float lsum) {
    const int lane = C.lane, hh = lane >> 5, l31 = lane & 31;
    const float il = 1.f / lsum;
    bf16_t* op = WSP(bf16_t, WS_BR) + ((size_t)2 * MTOK + q0 + l31) * 512 + h * 64 + 4 * hh;
#pragma unroll
    for (int qd = 0; qd < 4; ++qd) {
        *(u32x2*)(op + 8 * qd) = (u32x2){pk2(O0[4 * qd] * il, O0[4 * qd + 1] * il), pk2(O0[4 * qd + 2] * il, O0[4 * qd + 3] * il)};
        *(u32x2*)(op + 32 + 8 * qd) = (u32x2){pk2(O1[4 * qd] * il, O1[4 * qd + 1] * il), pk2(O1[4 * qd + 2] * il, O1[4 * qd + 3] * il)};
    }
}
DI void attn_phase(const Ctx& C, int layer) {
    LAS float* part = (LAS float*)(C.lds + ATT_PART_OFF) + (size_t)(C.wave & 3) * (34 * 64);
    const int half = C.wave >> 2;
    for (int it4 = C.bid; it4 < 256; it4 += C.G) {
        const int item = it4 * 4 + (C.wave & 3), qt = item & 63, h = (item >> 6) & 7, b = item >> 9, q0 = NCTX + b * 2048 + qt * 32;
        bf16x8 Q[6]; attn_q(C, layer, true, q0, qt, h, Q);
        f32x16 O0, O1;
#pragma unroll
        for (int q = 0; q < 16; ++q) { O0[q] = 0.f; O1[q] = 0.f; }
        float mrun = -1e30f, lrun = 0.f;
        attn_run(C, true, b, h, half * 40, 40, Q, O0, O1, mrun, lrun);
        if (half == 1) {
#pragma unroll
            for (int q = 0; q < 16; ++q) { part[q * 64 + C.lane] = O0[q]; part[(16 + q) * 64 + C.lane] = O1[q]; }
            part[32 * 64 + C.lane] = mrun; part[33 * 64 + C.lane] = lrun;
        }
        __syncthreads();
        if (half == 0) {
            const float m1 = part[32 * 64 + C.lane], l1 = part[33 * 64 + C.lane];
            const float m = fmaxf(mrun, m1), a0 = __builtin_amdgcn_exp2f(mrun - m), a1 = __builtin_amdgcn_exp2f(m1 - m);
#pragma unroll
            for (int q = 0; q < 16; ++q) { O0[q] = O0[q] * a0 + part[q * 64 + C.lane] * a1; O1[q] = O1[q] * a0 + part[(16 + q) * 64 + C.lane] * a1; }
            float lsum = lrun * a0 + l1 * a1; lsum += __shfl_xor(lsum, 32);
            attn_store(C, q0, h, O0, O1, lsum);
        }
        __syncthreads();
    }
    for (int it = C.bid; it < 256; it += C.G) {
        const int h = it & 7, b = it >> 3, qt = C.wave, q0 = b * 256 + qt * 32;
        bf16x8 Q[6]; attn_q(C, layer, false, q0, qt, h, Q);
        f32x16 O0, O1;
#pragma unroll
        for (int q = 0; q < 16; ++q) { O0[q] = 0.f; O1[q] = 0.f; }
        float mrun = -1e30f, lrun = 0.f;
        attn_run(C, false, b, h, 0, 8, Q, O0, O1, mrun, lrun);
        float lsum = lrun + __shfl_xor(lrun, 32);
        attn_store(C, q0, h, O0, O1, lsum);
    }
}

constexpr int PH_PER_LAYER = 11, N_PHASES = 1 + NLAYER * PH_PER_LAYER;

DI void set_sched(pg8::Sched& S, const void* A, const void* B, int lda, int ldb, int K, int nM, int nN, int nZ, int kind, size_t azs, size_t bzs) {
    S.A = (const char*)A; S.B = (const char*)B; S.azs = azs; S.bzs = bzs; S.lda = lda; S.ldb = ldb; S.K = K; S.nM = nM; S.nN = nN; S.nZ = nZ; S.kind = kind;
}
DI void set_epi(Epi& E, int mode, int perm, void* O, int ldc, size_t zstride, void* O2, const void* X0, const void* X1) {
    E.mode = mode; E.perm = perm; E.O = O; E.ldc = ldc; E.zstride = zstride; E.O2 = O2; E.X0 = X0; E.X1 = X1;
}
#define RUN_GEMM(SCHED_ARGS, EPI_ARGS) do { pg8::Sched S; S.G = C.G; S.c = C.bid; set_sched SCHED_ARGS; Epi E; set_epi EPI_ARGS; pg8::gemm_phase<Epi>(C.lds, S, E); } while (0)
#define RUN_GEMM_ON(GX, CX, SCHED_ARGS, EPI_ARGS) do { pg8::Sched S; S.G = (GX); S.c = (CX); set_sched SCHED_ARGS; Epi E; set_epi EPI_ARGS; pg8::gemm_phase<Epi>(C.lds, S, E); } while (0)
DI void run_phase(const Ctx& C, int ph) {
    if (ph == 0) { phase0(C); __syncthreads(); convert_weights(C, 0, 0, CW_ALL, C.gw, C.NGW); return; }
    const int layer = (ph - 1) / PH_PER_LAYER, sub = (ph - 1) % PH_PER_LAYER;
    const float* mod = WSP(float, WS_MOD) + (size_t)layer * 3 * 6144;
    switch (sub) {
    case 0:
        if (layer > 0) convert_weights(C, layer, C.G > 192 ? CW_FIN_END : 0, CW_ALL, C.gw, C.NGW);
        norm_rows(C, layer, layer == 0, 0); break;
    case 1:
        RUN_GEMM((S, WSP(bf16_t, WS_XN), WSP(bf16_t, WT_G1), 1024, 1024, 1024, 48, 29, 1, 0, 0, 0),
                 (E, M_G1, 1, WSP(bf16_t, WS_Z), 0, 0, WSP(bf16_t, WS_GATES), C.in[30] + layer * 4096, nullptr)); break;
    case 2:
        RUN_GEMM((S, WSP(bf16_t, WS_DCH), WSP(bf16_t, WS_Z) + OFF_FFT, 512, ZLD, 512, 4, 48, 1, 0, 0, 0), (E, M_FFT1, 1, WSP(bf16_t, WS_PQT), 0, 0, nullptr, nullptr, nullptr));
        pc_rows(C, layer); ssm_phase_a(C, layer); break;
    case 3: {
        const int NB = 64, GF = C.G - NB, cf = C.bid - NB;
        if (C.bid < NB || GF <= 0) {
            const int sh = (GF > 0 && C.bid >= 32) ? 1 : 0;
            for (int pass = 0; pass < (GF > 0 ? 1 : 2); ++pass) {
                const int s2 = GF > 0 ? sh : pass;
                RUN_GEMM_ON(GF > 0 ? 32 : C.G, GF > 0 ? C.bid - 32 * sh : C.bid,
                            (S, WSP(bf16_t, WS_DLAT) + s2 * 2048, WSP(bf16_t, WS_PQT) + PQT_LAT_EL + s2 * 2048, 4096, 8192, 2048, 8, 2, 2, 1, 0, (size_t)4096 * 2),
                            (E, M_BF16, 1, s2 ? WSP(bf16_t, WS_FT) : WSP(bf16_t, WS_BR) + ((size_t)1 * MTOK + NCTX) * 512, 512, (size_t)2048 * 512, nullptr, nullptr, nullptr));
            }
        }
        if (C.bid >= NB || GF <= 0) {
            const int gq = GF > 0 ? GF : C.G, c0 = GF > 0 ? cf : C.bid;
            RUN_GEMM_ON(gq, c0, (S, WSP(bf16_t, WS_CQN), WSP(bf16_t, WT_UQ), 384, 384, 384, 48, 3, 1, 0, 0, 0), (E, M_BF16, 1, WSP(bf16_t, WS_QRAW), 768, 0, nullptr, nullptr, nullptr));
            RUN_GEMM_ON(gq, (c0 + gq - 144 % gq) % gq, (S, WSP(bf16_t, WS_CKVN), WSP(bf16_t, WT_UKN), 256, 256, 256, 52, 2, 1, 0, 0, 0), (E, M_BF16, 1, WSP(bf16_t, WS_KNOPE), 512, 0, nullptr, nullptr, nullptr));
            RUN_GEMM_ON(gq, (c0 + 2 * gq - (144 + 104) % gq) % gq, (S, WSP(bf16_t, WT_UV), WSP(bf16_t, WS_CKVN), 256, 256, 256, 2, 52, 1, 0, 0, 0), (E, M_BF16, 1, WSP(bf16_t, WS_VT), MKV, 0, nullptr, nullptr, nullptr));
            RUN_GEMM_ON(gq, (c0 + 2 * gq - (144 + 208) % gq) % gq, (S, WSP(bf16_t, WS_DCTX), WSP(bf16_t, WS_PQT), 512, 16384, 512, 1, 2, 32, 1, 0, (size_t)512 * 2),
                        (E, M_BF16, 1, WSP(bf16_t, WS_BR) + (size_t)1 * MTOK * 512, 512, (size_t)256 * 512, nullptr, nullptr, nullptr));
            ssm_phase_b(C, layer, c0 * NWAVES + C.wave, gq * NWAVES);
        }
        break; }
    case 4:
        k_post(C, layer); ssm_finish(C, layer);
        for (int r = C.gw; r < NLAT; r += C.NGW) {
            bf16_t* dst = WSP(bf16_t, WS_BR) + ((size_t)1 * MTOK + NCTX + r) * 512 + 8 * C.lane;
            const u32x4 a = *(const u32x4*)dst, b = *(const u32x4*)(WSP(bf16_t, WS_FT) + (size_t)r * 512 + 8 * C.lane);
            u32x4 o; o.x = pk2(bflo(a.x) + bflo(b.x), bfhi(a.x) + bfhi(b.x)); o.y = pk2(bflo(a.y) + bflo(b.y), bfhi(a.y) + bfhi(b.y));
            o.z = pk2(bflo(a.z) + bflo(b.z), bfhi(a.z) + bfhi(b.z)); o.w = pk2(bflo(a.w) + bflo(b.w), bfhi(a.w) + bfhi(b.w));
            *(u32x4*)dst = o;
        }
        break;
    case 5:
        attn_phase(C, layer);
        __syncthreads();
        RUN_GEMM((S, WSP(bf16_t, WS_YPRE), WSP(bf16_t, WT_GLU), 512, 512, 512, 48, 2, 1, 0, 0, 0), (E, M_GLU, 1, WSP(bf16_t, WS_BR), 0, 0, nullptr, WSP(bf16_t, WS_YPRE), nullptr)); break;
    case 6:
        RUN_GEMM((S, WSP(bf16_t, WS_BR), WSP(bf16_t, WT_BR), 512, 512, 512, 48, 4, 4, 2, (size_t)MTOK * 512 * 2, (size_t)1024 * 512 * 2),
                 (E, M_BRANCH, 1, WSP(bf16_t, WS_Z), 0, 0, WSP(bf16_t, WS_XN), WSP(bf16_t, WS_GATES), nullptr));
        if (C.G > 192 && C.bid >= 192 && layer + 1 < NLAYER) convert_weights(C, layer + 1, 0, CW_GLU_END, (C.bid - 192) * NWAVES + C.wave, (C.G - 192) * NWAVES);
        break;
    case 7:
        RUN_GEMM((S, WSP(bf16_t, WS_XN), WSP(bf16_t, WT_OUT), 1024, 1024, 1024, 48, 4, 1, 0, 0, 0),
                 (E, M_RES, 0, WSP(float, WS_X), 0, 0, (void*)(mod + 2048), layer == 0 ? C.in[0] : WSP(float, WS_X), layer == 0 ? C.in[1] : WSP(float, WS_X) + (size_t)NCTX * 1024));
        if (C.G > 192 && C.bid >= 192 && layer + 1 < NLAYER) convert_weights(C, layer + 1, CW_GLU_END, CW_BR_END, (C.bid - 192) * NWAVES + C.wave, (C.G - 192) * NWAVES);
        break;
    case 8:
        norm_rows(C, layer, false, 1); break;
    case 9:
        RUN_GEMM((S, WSP(bf16_t, WS_XN), WSP(bf16_t, WT_FIN), 1024, 1024, 1024, 48, 22, 1, 0, 0, 0), (E, M_SWIGLU, 1, WSP(bf16_t, WS_Z), 0, 0, nullptr, nullptr, nullptr)); break;
    case 10:
        RUN_GEMM((S, WSP(bf16_t, WS_Z), WSP(bf16_t, WT_FOUT), DFF, DFF, DFF, 48, 4, 1, 0, 0, 0),
                 (E, M_RES, 0, layer == NLAYER - 1 ? C.out : WSP(float, WS_X), 0, 0, (void*)(mod + 5120), WSP(float, WS_X), WSP(float, WS_X) + (size_t)NCTX * 1024));
        if (C.G > 192 && C.bid >= 192 && layer + 1 < NLAYER) convert_weights(C, layer + 1, CW_BR_END, CW_FIN_END, (C.bid - 192) * NWAVES + C.wave, (C.G - 192) * NWAVES);
        break;
    }
}

#define XB_TMO      128
#define XB_XCNT(j)  (256  + 64 * (j))
#define XB_XSUB(j)  (1280 + 64 * (j))
#define XB_XGEN(j)  (2304 + 64 * (j))
#define XB_TOP      3328
#define XB_TOPGEN   3392
#define XCD_BAR_WORDS 3456
#define XB_SPIN_CAP (1u << 18)

__device__ __forceinline__ unsigned xb_ld(unsigned* p)              { return __hip_atomic_load(p, __ATOMIC_RELAXED, __HIP_MEMORY_SCOPE_AGENT); }
__device__ __forceinline__ unsigned xb_add(unsigned* p, unsigned v) { return __hip_atomic_fetch_add(p, v, __ATOMIC_RELAXED, __HIP_MEMORY_SCOPE_AGENT); }
__device__ __forceinline__ unsigned xb_xcc_id() { return (unsigned)__builtin_amdgcn_s_getreg((3 << 11) | 20) & 0xFu; }
#define XB_SPIN(cond, bar) do { unsigned _sp = 0; while (cond) { __builtin_amdgcn_s_sleep(1); \
    if ((++_sp & 255u) == 0u) { if (xb_ld(&(bar)[XB_TMO])) break; if (_sp > XB_SPIN_CAP) { atomicAdd(&(bar)[XB_TMO], 1u); break; } } } } while (0)

struct XcdBarrier {
    unsigned* bar; unsigned x;
    volatile LAS unsigned* st;
};

__device__ __forceinline__ XcdBarrier xcd_barrier_post(unsigned* bar, volatile LAS unsigned* st) {
    XcdBarrier b; b.bar = bar; b.x = xb_xcc_id(); b.st = st;
    if (threadIdx.x == 0) (void)xb_add(&bar[XB_XCNT(b.x)], 1u);
    return b;
}
__device__ __forceinline__ void xcd_barrier_complete(unsigned* bar, unsigned x, unsigned& nloc, unsigned& nx) {
    const unsigned G = gridDim.x * gridDim.y * gridDim.z;
    unsigned sum, cnt, mine, sp = 0u;
    for (;;) {
        sum = 0u; cnt = 0u; mine = 0u;
#pragma unroll
        for (unsigned j = 0; j < 16; ++j) { const unsigned c = xb_ld(&bar[XB_XCNT(j)]); sum += c; cnt += (c > 0u) ? 1u : 0u; mine = (j == x) ? c : mine; }
        if (sum == G) break;
        __builtin_amdgcn_s_sleep(1);
        if ((++sp & 255u) == 0u) { if (xb_ld(&bar[XB_TMO])) break; if (sp > XB_SPIN_CAP) { atomicAdd(&bar[XB_TMO], 1u); break; } }
    }
    nloc = mine > 0u ? mine : 1u; nx = cnt > 0u ? cnt : 1u;
}

__device__ __forceinline__ void xcd_barrier(const XcdBarrier& b) {
    asm volatile("s_waitcnt vmcnt(0)" ::: "memory");
    __syncthreads();
    if (threadIdx.x == 0) {
        unsigned* bar = b.bar;
        __builtin_amdgcn_s_waitcnt(0);
        unsigned nloc = b.st[0], nx = b.st[1];
        if (nloc == 0u) { xcd_barrier_complete(bar, b.x, nloc, nx); b.st[0] = nloc; b.st[1] = nx; }
        const unsigned old = xb_add(&bar[XB_XSUB(b.x)], 1u);
        const unsigned gen = old / nloc;
        if (old + 1u == (gen + 1u) * nloc) {
            __builtin_amdgcn_fence(__ATOMIC_RELEASE, "agent");
            asm volatile("s_waitcnt vmcnt(0)" ::: "memory");
            const unsigned og = xb_add(&bar[XB_TOP], 1u);
            const unsigned tg = og / nx;
            if (og + 1u == (tg + 1u) * nx) xb_add(&bar[XB_TOPGEN], 1u);
            else XB_SPIN(xb_ld(&bar[XB_TOPGEN]) == tg, bar);
            __builtin_amdgcn_fence(__ATOMIC_ACQUIRE, "agent");
            xb_add(&bar[XB_XGEN(b.x)], 1u);
            asm volatile("s_waitcnt vmcnt(0)" ::: "memory");
        } else {
            XB_SPIN(xb_ld(&bar[XB_XGEN(b.x)]) == gen, bar);
            __builtin_amdgcn_fence(__ATOMIC_ACQUIRE, "agent");
            asm volatile("s_waitcnt vmcnt(0)" ::: "memory");
        }
    }
    __syncthreads();
}

__global__ void __launch_bounds__(NTHREADS, 2) mega_fwd(Args args) {
    extern __shared__ __attribute__((aligned(16))) unsigned char lds_raw[];
    Ctx C; C.in = args.in; C.out = args.out; C.ws = args.ws; C.lds = (LAS unsigned char*)lds_raw;
    cg::grid_group grid = cg::this_grid();
    volatile LAS unsigned* bst = (volatile LAS unsigned*)((LAS unsigned char*)lds_raw + 131072);
    if (threadIdx.x < 4) bst[threadIdx.x] = 0u;
    __syncthreads();
    if (args.ph_lo < 0) grid.sync();
    XcdBarrier xbar = xcd_barrier_post((unsigned*)(args.ws + WS_BAR), bst);
    for (int ph = args.ph_lo; ph < args.ph_hi; ++ph) {
        int tid = threadIdx.x; asm volatile("" : "+v"(tid));
        C.tid = tid; C.lane = C.tid & 63; C.wave = __builtin_amdgcn_readfirstlane(C.tid >> 6); C.G = gridDim.x; C.bid = blockIdx.x;
        C.gw = C.bid * NWAVES + C.wave; C.NGW = C.G * NWAVES;
        run_phase(C, ph);
        if (ph + 1 < args.ph_hi) xcd_barrier(xbar);
    }
}

extern "C" void kernel_launch(void* const* d_in, const int* in_sizes, int n_in, void* d_out, int out_size, void* d_ws, size_t ws_size, hipStream_t stream) {
    static int grid = 0;
    if (grid == 0) {
        if (n_in != 34 || ws_size < WS_END) { fprintf(stderr, "kernel_launch: n_in %d ws %zu (need %zu)\n", n_in, ws_size, (size_t)WS_END); grid = -1; return; }
        int dev = 0, cus = 0, per_cu = 0;
        hipGetDevice(&dev); hipDeviceGetAttribute(&cus, hipDeviceAttributeMultiprocessorCount, dev);
        hipFuncSetAttribute((const void*)mega_fwd, hipFuncAttributeMaxDynamicSharedMemorySize, LDS_BYTES);
        hipOccupancyMaxActiveBlocksPerMultiprocessor(&per_cu, (const void*)mega_fwd, NTHREADS, LDS_BYTES);
        if (per_cu < 1) per_cu = 1;
        grid = cus * 1;
        (void)hipGetLastError();
    }
    if (grid < 0) return;
    if (hipMemsetAsync((char*)d_ws + WS_BAR, 0, 16384, stream) != hipSuccess) { fprintf(stderr, "memset failed\n"); return; }
    Args a{};
    for (int i = 0; i < 34; ++i) a.in[i] = (const float*)d_in[i];
    a.out = (float*)d_out; a.ws = (unsigned char*)d_ws;
#if N_LAUNCH_MODE == 0
    a.ph_lo = 0; a.ph_hi = N_PHASES;
    void* kargs[] = {&a};
    hipError_t e = hipLaunchCooperativeKernel((const void*)mega_fwd, dim3(grid), dim3(NTHREADS), kargs, LDS_BYTES, stream);
    if (e != hipSuccess) fprintf(stderr, "cooperative launch failed: %s (grid %d)\n", hipGetErrorString(e), grid);
#else
    for (int ph = 0; ph < N_PHASES; ++ph) { a.ph_lo = ph; a.ph_hi = ph + 1; hipLaunchKernelGGL(mega_fwd, dim3(grid), dim3(NTHREADS), LDS_BYTES, stream, a); }
#endif
}
```

```cpp
#include <hip/hip_runtime.h>
#include <hip/hip_cooperative_groups.h>
#include <cstdio>
#include <cstdint>
namespace cg = cooperative_groups;

#define DI __device__ __forceinline__
#define LAS __attribute__((address_space(3)))
typedef unsigned short bf16_t;
typedef short bf16x8 __attribute__((ext_vector_type(8)));
typedef float f32x4 __attribute__((ext_vector_type(4)));
typedef float f32x2 __attribute__((ext_vector_type(2)));
typedef float f32x16 __attribute__((ext_vector_type(16)));
typedef unsigned u32x4 __attribute__((ext_vector_type(4)));
typedef unsigned u32x2 __attribute__((ext_vector_type(2)));
typedef __bf16 bf16x2_t __attribute__((ext_vector_type(2)));

#ifndef N_LAUNCH_MODE
#define N_LAUNCH_MODE 0
#endif

constexpr int DM = 1024, NCTX = 8192, NLAT = 4096, MTOK = 12288, MKV = 13312, NLAYER = 4;
constexpr int ZLD = 3328, NG1 = 7424, DFF = 2816;
constexpr int OFF_FFT = 512, OFF_CQ = 1024, OFF_CKV = 1408, OFF_KPE = 1664, OFF_HIN = 1696, OFF_GB = 2208, OFF_GC = 2720;
constexpr float EPS = 1e-6f;
constexpr int NTHREADS = 512, NWAVES = 8;
constexpr int LDS_BYTES = 131072 + 16;

constexpr size_t al256(size_t x) { return (x + 255) & ~(size_t)255; }
constexpr size_t WT_G1 = 0;
constexpr size_t WT_UQ = WT_G1 + (size_t)NG1 * 1024 * 2;
constexpr size_t WT_UKN = WT_UQ + (size_t)768 * 384 * 2;
constexpr size_t WT_UV = WT_UKN + (size_t)512 * 256 * 2;
constexpr size_t WT_GLU = WT_UV + (size_t)512 * 256 * 2;
constexpr size_t WT_BR = WT_GLU + (size_t)512 * 512 * 2;
constexpr size_t WT_OUT = WT_BR + (size_t)4 * 1024 * 512 * 2;
constexpr size_t WT_FIN = WT_OUT + (size_t)1024 * 1024 * 2;
constexpr size_t WT_FOUT = WT_FIN + (size_t)5632 * 1024 * 2;
constexpr size_t WS_Z = al256(WT_FOUT + (size_t)1024 * 2816 * 2);
constexpr size_t WS_GATES = WS_Z + (size_t)MTOK * ZLD * 2;
constexpr size_t WS_XN = WS_GATES + (size_t)MTOK * 4096 * 2;
constexpr size_t WS_CQN = WS_XN + (size_t)MTOK * 1024 * 2;
constexpr size_t WS_CKVN = WS_CQN + (size_t)MTOK * 384 * 2;
constexpr size_t WS_QRAW = WS_CKVN + (size_t)MKV * 256 * 2;
constexpr size_t WS_KNOPE = WS_QRAW + (size_t)MTOK * 768 * 2;
constexpr size_t WS_VT = WS_KNOPE + (size_t)MKV * 512 * 2;
constexpr size_t WS_K = WS_VT + (size_t)512 * MKV * 2;
constexpr size_t WS_PQT = WS_K + (size_t)MKV * 768 * 2;
constexpr size_t PQT_LAT_EL = (size_t)512 * 16384;
constexpr size_t WS_BR = WS_PQT + (size_t)512 * 24576 * 2;
constexpr size_t WS_YPRE = WS_CQN;
constexpr size_t WS_X = WS_BR + (size_t)4 * MTOK * 512 * 2;
constexpr size_t WS_DCH = WS_X + (size_t)MTOK * 1024 * 4;
constexpr size_t WS_DCTX = WS_DCH + (size_t)1024 * 512 * 2;
constexpr size_t WS_DLAT = WS_DCTX + (size_t)256 * 512 * 2;
constexpr size_t WS_MOD = WS_DLAT + (size_t)2048 * 4096 * 2;
constexpr size_t WS_ROPE = al256(WS_MOD + (size_t)4 * 3 * 6144 * 4);
constexpr size_t WS_SSMA = WS_ROPE + (size_t)2048 * 32 * 4;
constexpr size_t WS_BBC = WS_SSMA + (size_t)256 * 64 * 4 * 4;
constexpr size_t WS_CCAT = WS_BBC + (size_t)256 * 128 * 16 * 2;
constexpr size_t WS_CST = WS_CCAT + (size_t)256 * 16 * 128 * 2;
constexpr size_t WS_BAR = WS_CST + (size_t)2 * 2 * 32 * 8 * 128 * 4;
constexpr size_t WS_FT = WS_BAR + 16384;
constexpr size_t WS_END = WS_FT + (size_t)NLAT * 512 * 2;

constexpr size_t OUT_CKV = (size_t)MTOK * 1024, OUT_KPE = OUT_CKV + (size_t)32 * 4 * 256 * 256, OUT_SSM = OUT_KPE + (size_t)32 * 4 * 256 * 32;

DI unsigned pk2(float a, float b) { f32x2 v = {a, b}; bf16x2_t r = __builtin_convertvector(v, bf16x2_t); return __builtin_bit_cast(unsigned, r); }
DI float bflo(unsigned u) { return __uint_as_float(u << 16); }
DI float bfhi(unsigned u) { return __uint_as_float(u & 0xffff0000u); }
DI float sigmoidf_(float x) { return __builtin_amdgcn_rcpf(1.f + __builtin_amdgcn_exp2f(-1.44269504f * x)); }
DI float siluf_(float x) { return x * sigmoidf_(x); }
DI float geluf_(float x) { const float y = 0.7978845608f * (x + 0.044715f * x * x * x); return x * sigmoidf_(2.f * y); }
DI float wave_sum(float v) {
#pragma unroll
    for (int o = 1; o < 64; o <<= 1) v += __shfl_xor(v, o);
    return v;
}
DI void keep(const bf16x8& v) { asm volatile("" :: "v"(v)); }
DI void opaque16(f32x16& v) { asm volatile("" : "+v"(v)); }
DI void opaque4(f32x4& v) { asm volatile("" : "+v"(v)); }
DI int cond_of(int r) { return r < NCTX ? 0 : 1 + ((r - NCTX) >> 11); }

namespace pg8 {
constexpr int BM = 256, BK = 64, HALF = 128, HTB = HALF * BK * 2, STAGE_BYTES = 8 * HTB, NXCD = 8, WGM = 8;
DI int lds_byte(int r, int c) { const int st = (r >> 4) * 2 + (c >> 5), rr = r & 15, cc = c & 31, ob = rr * 64 + cc * 2; return st * 1024 + (ob ^ (((ob >> 9) & 1) << 5)); }
DI void stage_rc(int b, int& R, int& C) { const int st = b / 1024, sb = b % 1024, swz = sb ^ (((sb >> 9) & 1) << 5); R = (st >> 1) * 16 + swz / 64; C = (st & 1) * 32 + (swz % 64) / 2; }
DI int perm32(int rho) { const int n = rho >> 4, i = rho & 15; return 8 * (i >> 2) + 4 * n + (i & 3); }

struct Unit { int pm, pn, z; };
struct Sched {
    const char* A; const char* B; size_t azs, bzs;
    int lda, ldb, K, nM, nN, nZ, kind, G, c;
    DI bool next(int i, Unit& u) const {
        const int nwg = nM * nN;
        if (kind == 2) {
            const long L = (long)(i / nZ) * G + c; if (L >= nwg) return false;
            u.z = i % nZ; u.pm = (int)L / nN; u.pn = (int)L % nN; return true;
        }
        const long L = (long)i * G + c;
        if (kind == 1) { if (L >= (long)nwg * nZ) return false; u.z = (int)(L / nwg); const int r = (int)(L % nwg); u.pm = r / nN; u.pn = r % nN; return true; }
        if (L >= nwg) return false;
        int wgid = (int)L; { const int q = nwg / NXCD, r = nwg % NXCD, xcd = wgid % NXCD, off = wgid / NXCD; wgid = (xcd < r ? xcd * (q + 1) : r * (q + 1) + (xcd - r) * q) + off; }
        const int nig = WGM * nN, gid = wgid / nig, fm = gid * WGM, gsz = (nM - fm) < WGM ? (nM - fm) : WGM;
        u.pm = fm + ((wgid % nig) % gsz); u.pn = (wgid % nig) / gsz; u.z = 0; return true;
    }
    DI const char* aptr(const Unit& u) const { return A + (size_t)u.z * azs + (size_t)u.pm * (size_t)(BM * 2) * lda; }
    DI const char* bptr(const Unit& u) const { return B + (size_t)u.z * bzs + (size_t)u.pn * (size_t)(BM * 2) * ldb; }
};

template <class Epi>
DI void gemm_phase(LAS unsigned char* lds, const Sched& S, const Epi& E) {
    int tid = threadIdx.x; asm volatile("" : "+v"(tid));
    const int wid = __builtin_amdgcn_readfirstlane(tid >> 6), lane = tid & 63, wr = wid >> 2, wc = wid & 3, fr = lane & 15, fq = lane >> 4;
    const int K = S.K, nt = K / BK;
    unsigned voffA[2], voffB[2];
#pragma unroll
    for (int i = 0; i < 2; ++i) { int R, C; stage_rc(tid * 16 + i * 8192, R, C); const int Rb = E.perm ? ((R & ~31) + perm32(R & 31)) : R;
        voffA[i] = (unsigned)(R * S.lda + C) * 2u; voffB[i] = (unsigned)(Rb * S.ldb + C) * 2u; }
    const size_t kstep = (size_t)(BK * 2);
    const size_t hstepA = (size_t)HALF * S.lda * 2, hstepB = (size_t)HALF * S.ldb * 2;
    const unsigned ldsw = (unsigned)wid * 1024u;
    const int aoff = lds_byte(wr * 64 + fr, fq * 8), boff = lds_byte(wc * 32 + fr, fq * 8);
#define PG8_SA(b, h) (((b) * 2 + (h)) * HTB)
#define PG8_SB(b, h) ((4 + (b) * 2 + (h)) * HTB)
#define PG8_STAGE(bufoff, gbase, voff) do { _Pragma("unroll") for (int _i = 0; _i < 2; ++_i) \
        __builtin_amdgcn_global_load_lds((const unsigned*)((const char*)(gbase) + (voff)[_i]), (LAS unsigned*)(lds + (bufoff) + ldsw + _i * 8192), 16, 0, 0); } while (0)
#define PG8_LDA(dst, b, h) do { _Pragma("unroll") for (int m = 0; m < 4; ++m) _Pragma("unroll") for (int k = 0; k < 2; ++k) dst[m][k] = *(const LAS bf16x8*)(lds + PG8_SA(b, h) + aoff + m * 2048 + k * 1024); } while (0)
#define PG8_LDB(dst, b, h) do { _Pragma("unroll") for (int n = 0; n < 2; ++n) _Pragma("unroll") for (int k = 0; k < 2; ++k) dst[n][k] = *(const LAS bf16x8*)(lds + PG8_SB(b, h) + boff + n * 2048 + k * 1024); } while (0)
#define PG8_MMA(ai, bj, At, Bt) do { __builtin_amdgcn_s_setprio(1); _Pragma("unroll") for (int m = 0; m < 4; ++m) _Pragma("unroll") for (int n = 0; n < 2; ++n) _Pragma("unroll") for (int k = 0; k < 2; ++k) \
        acc[ai][bj][m][n] = __builtin_amdgcn_mfma_f32_16x16x32_bf16(Bt[n][k], At[m][k], acc[ai][bj][m][n], 0, 0, 0); __builtin_amdgcn_s_setprio(0); } while (0)
#define PG8_WAIT_V(n) asm volatile("s_waitcnt vmcnt(" #n ")" ::: "memory")
#define PG8_WAIT_L(n) asm volatile("s_waitcnt lgkmcnt(" #n ")" ::: "memory")
#define PG8_BAR __builtin_amdgcn_s_barrier()
#define PG8_SCHED __builtin_amdgcn_sched_barrier(0)
    Unit cur, nxt; int ui = 0;
    if (!S.next(0, cur)) return;
    f32x4 acc[2][2][4][2];
#pragma unroll
    for (int a = 0; a < 2; ++a)
#pragma unroll
        for (int b = 0; b < 2; ++b)
#pragma unroll
            for (int m = 0; m < 4; ++m)
#pragma unroll
                for (int n = 0; n < 2; ++n) acc[a][b][m][n] = (f32x4){0.f, 0.f, 0.f, 0.f};
    bf16x8 At[4][2], B0[2][2], B1[2][2];
    const char* cA = S.aptr(cur); const char* cB = S.bptr(cur);
    PG8_STAGE(PG8_SB(0, 0), cB, voffB); PG8_STAGE(PG8_SA(0, 0), cA, voffA); PG8_STAGE(PG8_SB(0, 1), cB + hstepB, voffB); PG8_STAGE(PG8_SA(0, 1), cA + hstepA, voffA);
    if (wr == 1) PG8_BAR;
    PG8_WAIT_V(4); PG8_BAR;
    PG8_STAGE(PG8_SB(1, 0), cB + kstep, voffB); PG8_STAGE(PG8_SA(1, 0), cA + kstep, voffA); PG8_STAGE(PG8_SB(1, 1), cB + hstepB + kstep, voffB);
    PG8_WAIT_V(6); PG8_BAR;
    for (;;) {
        const bool has_next = S.next(ui + 1, nxt);
        const char* nA = has_next ? S.aptr(nxt) : cA; const char* nB = has_next ? S.bptr(nxt) : cB;
        for (int t = 0; t < nt; t += 2) {
            const bool last = (t == nt - 2);
            const char* a1 = cA + (size_t)(t + 1) * kstep;
            const char* a2 = last ? nA : cA + (size_t)(t + 2) * kstep; const char* b2 = last ? nB : cB + (size_t)(t + 2) * kstep;
            const char* a3 = a2 + kstep; const char* b3 = b2 + kstep;
            PG8_LDB(B0, 0, 0); PG8_SCHED; PG8_LDA(At, 0, 0); PG8_STAGE(PG8_SA(1, 1), a1 + hstepA, voffA);
            PG8_WAIT_L(8); PG8_BAR; PG8_WAIT_L(0); PG8_MMA(0, 0, At, B0); PG8_BAR; PG8_SCHED;
            PG8_LDB(B1, 0, 1); PG8_STAGE(PG8_SB(0, 0), b2, voffB);
            PG8_BAR; PG8_WAIT_L(0); PG8_MMA(0, 1, At, B1); PG8_BAR;
            PG8_LDA(At, 0, 1); PG8_STAGE(PG8_SA(0, 0), a2, voffA);
            PG8_BAR; PG8_WAIT_L(0); PG8_MMA(1, 0, At, B0); PG8_BAR; PG8_SCHED;
            PG8_STAGE(PG8_SB(0, 1), b2 + hstepB, voffB);
            PG8_WAIT_V(6); PG8_BAR; PG8_MMA(1, 1, At, B1); PG8_BAR;
            PG8_LDB(B0, 1, 0); PG8_SCHED; PG8_LDA(At, 1, 0); PG8_STAGE(PG8_SA(0, 1), a2 + hstepA, voffA);
            PG8_WAIT_L(8); PG8_BAR; PG8_WAIT_L(0); PG8_MMA(0, 0, At, B0); PG8_BAR; PG8_SCHED;
            PG8_LDB(B1, 1, 1); PG8_STAGE(PG8_SB(1, 0), b3, voffB);
            PG8_BAR; PG8_WAIT_L(0); PG8_MMA(0, 1, At, B1); PG8_BAR;
            PG8_LDA(At, 1, 1); PG8_STAGE(PG8_SA(1, 0), a3, voffA);
            PG8_BAR; PG8_WAIT_L(0); PG8_MMA(1, 0, At, B0); PG8_BAR; PG8_SCHED;
            PG8_STAGE(PG8_SB(1, 1), b3 + hstepB, voffB);
            PG8_WAIT_V(6); PG8_BAR; PG8_MMA(1, 1, At, B1); PG8_BAR;
        }
        E(acc, cur, wr, wc, fr, fq);
        if (!has_next) break;
#pragma unroll
        for (int a = 0; a < 2; ++a)
#pragma unroll
            for (int b = 0; b < 2; ++b)
#pragma unroll
                for (int m = 0; m < 4; ++m)
#pragma unroll
                    for (int n = 0; n < 2; ++n) acc[a][b][m][n] = (f32x4){0.f, 0.f, 0.f, 0.f};
        cur = nxt; cA = nA; cB = nB; ++ui;
    }
    PG8_WAIT_V(0);
    if (wr == 0) PG8_BAR;
    PG8_BAR;
#undef PG8_SA
#undef PG8_SB
#undef PG8_STAGE
#undef PG8_LDA
#undef PG8_LDB
#undef PG8_MMA
#undef PG8_WAIT_V
#undef PG8_WAIT_L
#undef PG8_BAR
#undef PG8_SCHED
}
}

enum { M_BF16 = 0, M_G1 = 1, M_FFT1 = 2, M_GLU = 3, M_SWIGLU = 4, M_RES = 5, M_BRANCH = 6 };
struct Epi {
    int mode, perm, ldc; size_t zstride;
    void* O; void* O2; const void* X0; const void* X1;
    DI void operator()(const f32x4 (&acc)[2][2][4][2], const pg8::Unit& u, int wr, int wc, int fr, int fq) const {
        const int row0 = u.pm * 256 + wr * 64 + fr;
        if (mode == M_SWIGLU) {
#pragma unroll
            for (int ai = 0; ai < 2; ++ai)
#pragma unroll
                for (int m = 0; m < 4; ++m) {
                    const int r = row0 + ai * 128 + m * 16;
                    const f32x4 g0 = acc[ai][0][m][0], g1 = acc[ai][0][m][1], u0 = acc[ai][1][m][0], u1 = acc[ai][1][m][1];
                    u32x4 o; o.x = pk2(siluf_(g0[0]) * u0[0], siluf_(g0[1]) * u0[1]); o.y = pk2(siluf_(g0[2]) * u0[2], siluf_(g0[3]) * u0[3]);
                    o.z = pk2(siluf_(g1[0]) * u1[0], siluf_(g1[1]) * u1[1]); o.w = pk2(siluf_(g1[2]) * u1[2], siluf_(g1[3]) * u1[3]);
                    *(u32x4*)((bf16_t*)O + (size_t)r * DFF + u.pn * 128 + wc * 32 + 8 * fq) = o;
                }
            return;
        }
        if (mode == M_RES) {
            const int col0 = u.pn * 256 + wc * 32 + 4 * fq;
            const float* gvp = (const float*)O2 + cond_of(row0) * 6144 + col0;
            f32x4 gv[2][2];
#pragma unroll
            for (int bj = 0; bj < 2; ++bj)
#pragma unroll
                for (int n = 0; n < 2; ++n) gv[bj][n] = *(const f32x4*)(gvp + bj * 128 + n * 16);
            const float* xbase = row0 < NCTX ? (const float*)X0 + (size_t)row0 * 1024 : (const float*)X1 + (size_t)(row0 - NCTX) * 1024;
#pragma unroll
            for (int ai = 0; ai < 2; ++ai)
#pragma unroll
                for (int mh = 0; mh < 2; ++mh) {
                    f32x4 xo[2][2][2];
#pragma unroll
                    for (int mm = 0; mm < 2; ++mm)
#pragma unroll
                        for (int bj = 0; bj < 2; ++bj)
#pragma unroll
                            for (int n = 0; n < 2; ++n) xo[mm][bj][n] = *(const f32x4*)(xbase + (size_t)(ai * 128 + (2 * mh + mm) * 16) * 1024 + col0 + bj * 128 + n * 16);
#pragma unroll
                    for (int mm = 0; mm < 2; ++mm)
#pragma unroll
                        for (int bj = 0; bj < 2; ++bj)
#pragma unroll
                            for (int n = 0; n < 2; ++n) { const int r = row0 + ai * 128 + (2 * mh + mm) * 16, c = col0 + bj * 128 + n * 16;
                                *(f32x4*)((float*)O + (size_t)r * 1024 + c) = xo[mm][bj][n] + gv[bj][n] * acc[ai][bj][2 * mh + mm][n]; }
                }
            return;
        }
        if (mode == M_BRANCH) {
            const int col0 = u.pn * 256 + wc * 32 + 8 * fq, k = u.z, ftid = (wr * 4 + wc) * 64 + fq * 16 + fr;
#pragma unroll
            for (int ai = 0; ai < 2; ++ai) {
                u32x4 gt[4][2], mv[4][2];
#pragma unroll
                for (int m = 0; m < 4; ++m)
#pragma unroll
                    for (int bj = 0; bj < 2; ++bj) {
                        gt[m][bj] = *(const u32x4*)((const bf16_t*)X0 + ((size_t)((u.pm * 16 + 4 * k + u.pn) * 16 + ai * 8 + m * 2 + bj) * 512 + ftid) * 8);
                        if (k > 0) mv[m][bj] = *(const u32x4*)((const bf16_t*)O + ((size_t)((u.pm * 4 + u.pn) * 16 + ai * 8 + m * 2 + bj) * 512 + ftid) * 8); }
#pragma unroll
                for (int m = 0; m < 4; ++m)
#pragma unroll
                    for (int bj = 0; bj < 2; ++bj) { const int r = row0 + ai * 128 + m * 16, c = col0 + bj * 128;
                        const u32x4 g4 = gt[m][bj]; f32x4 v0 = acc[ai][bj][m][0], v1 = acc[ai][bj][m][1];
                        v0[0] *= bflo(g4.x); v0[1] *= bfhi(g4.x); v0[2] *= bflo(g4.y); v0[3] *= bfhi(g4.y);
                        v1[0] *= bflo(g4.z); v1[1] *= bfhi(g4.z); v1[2] *= bflo(g4.w); v1[3] *= bfhi(g4.w);
                        if (k > 0) { const u32x4 p4 = mv[m][bj];
                            v0[0] += bflo(p4.x); v0[1] += bfhi(p4.x); v0[2] += bflo(p4.y); v0[3] += bfhi(p4.y);
                            v1[0] += bflo(p4.z); v1[1] += bfhi(p4.z); v1[2] += bflo(p4.w); v1[3] += bfhi(p4.w); }
                        u32x4 o; o.x = pk2(v0[0], v0[1]); o.y = pk2(v0[2], v0[3]); o.z = pk2(v1[0], v1[1]); o.w = pk2(v1[2], v1[3]);
                        if (k < 3) *(u32x4*)((bf16_t*)O + ((size_t)((u.pm * 4 + u.pn) * 16 + ai * 8 + m * 2 + bj) * 512 + ftid) * 8) = o;
                        else *(u32x4*)((bf16_t*)O2 + (size_t)r * 1024 + c) = o; }
            }
            return;
        }
        if (mode == M_GLU) {
            const int col0 = u.pn * 256 + wc * 32 + 8 * fq;
#pragma unroll
            for (int ai = 0; ai < 2; ++ai) {
                u32x4 yv[4][2];
#pragma unroll
                for (int m = 0; m < 4; ++m)
#pragma unroll
                    for (int bj = 0; bj < 2; ++bj) yv[m][bj] = *(const u32x4*)((const bf16_t*)X0 + (size_t)(row0 + ai * 128 + m * 16) * 512 + col0 + bj * 128);
#pragma unroll
                for (int m = 0; m < 4; ++m)
#pragma unroll
                    for (int bj = 0; bj < 2; ++bj) { const u32x4 y = yv[m][bj]; const f32x4 v0 = acc[ai][bj][m][0], v1 = acc[ai][bj][m][1];
                        u32x4 o; o.x = pk2(bflo(y.x) * sigmoidf_(v0[0]), bfhi(y.x) * sigmoidf_(v0[1])); o.y = pk2(bflo(y.y) * sigmoidf_(v0[2]), bfhi(y.y) * sigmoidf_(v0[3]));
                        o.z = pk2(bflo(y.z) * sigmoidf_(v1[0]), bfhi(y.z) * sigmoidf_(v1[1])); o.w = pk2(bflo(y.w) * sigmoidf_(v1[2]), bfhi(y.w) * sigmoidf_(v1[3]));
                        *(u32x4*)((bf16_t*)O + (size_t)(row0 + ai * 128 + m * 16) * 512 + col0 + bj * 128) = o; }
            }
            return;
        }
        if (mode == M_G1 && u.pn >= 13) {
            const int cc0 = u.pn * 256 + wc * 32 + 8 * fq - ZLD;
            f32x4 bb[2][2];
#pragma unroll
            for (int bj = 0; bj < 2; ++bj) { bb[bj][0] = *(const f32x4*)((const float*)X0 + cc0 + bj * 128); bb[bj][1] = *(const f32x4*)((const float*)X0 + cc0 + bj * 128 + 4); }
#pragma unroll
            for (int ai = 0; ai < 2; ++ai)
#pragma unroll
                for (int m = 0; m < 4; ++m)
#pragma unroll
                    for (int bj = 0; bj < 2; ++bj) { const f32x4 v0 = acc[ai][bj][m][0] + bb[bj][0], v1 = acc[ai][bj][m][1] + bb[bj][1];
                        u32x4 o; o.x = pk2(sigmoidf_(v0[0]), sigmoidf_(v0[1])); o.y = pk2(sigmoidf_(v0[2]), sigmoidf_(v0[3])); o.z = pk2(sigmoidf_(v1[0]), sigmoidf_(v1[1])); o.w = pk2(sigmoidf_(v1[2]), sigmoidf_(v1[3]));
                        *(u32x4*)((bf16_t*)O2 + ((size_t)((u.pm * 16 + (u.pn - 13)) * 16 + ai * 8 + m * 2 + bj) * 512 + (wr * 4 + wc) * 64 + fq * 16 + fr) * 8) = o; }
            return;
        }
        const int col0 = u.pn * 256 + wc * 32 + 8 * fq;
#pragma unroll
        for (int ai = 0; ai < 2; ++ai)
#pragma unroll
            for (int m = 0; m < 4; ++m) {
                const int r = row0 + ai * 128 + m * 16;
#pragma unroll
                for (int bj = 0; bj < 2; ++bj) {
                    const int c = col0 + bj * 128;
                    f32x4 v0 = acc[ai][bj][m][0], v1 = acc[ai][bj][m][1];
                    bf16_t* dst;
                    if (mode == M_BF16) { dst = (bf16_t*)O + (size_t)u.z * zstride + (size_t)r * ldc + c; }
                    else if (mode == M_G1) { dst = (bf16_t*)O + (size_t)r * ZLD + c; }
                    else {
                        const int g = r >> 8, pq = (r >> 7) & 1, mm = r & 127, nidx = g * 128 + mm;
                        if (c < NCTX) dst = (bf16_t*)O + (size_t)nidx * 16384 + (c >> 8) * 512 + pq * 256 + (c & 255);
                        else { const int t = c - NCTX; dst = (bf16_t*)O + PQT_LAT_EL + (size_t)nidx * 8192 + (t >> 11) * 4096 + pq * 2048 + (t & 2047); }
                    }
                    u32x4 o; o.x = pk2(v0[0], v0[1]); o.y = pk2(v0[2], v0[3]); o.z = pk2(v1[0], v1[1]); o.w = pk2(v1[2], v1[3]);
                    *(u32x4*)dst = o;
                }
            }
    }
};

struct Args { const float* in[34]; float* out; unsigned char* ws; int ph_lo, ph_hi; };
struct Ctx {
    const float* const* in; float* out; unsigned char* ws; LAS unsigned char* lds;
    int tid, lane, wave, G, bid, gw, NGW;
};
#define WSP(T, off) ((T*)(C.ws + (off)))

DI void transpose_item(const float* W, int N, bf16_t* WTrow0  , int ldt, int k0, int n0, LAS float* scr, int lane) {
#pragma unroll 8
    for (int i = 0; i < 32; ++i) { const int kk = 2 * i + (lane >> 5); scr[kk * 33 + (lane & 31)] = W[(size_t)(k0 + kk) * N + n0 + (lane & 31)]; }
    const int c = lane & 7;
#pragma unroll
    for (int j = 0; j < 4; ++j) { const int n = (lane >> 3) + 8 * j; const LAS float* s = scr + (8 * c) * 33 + n;
        u32x4 o; o.x = pk2(s[0], s[33]); o.y = pk2(s[2 * 33], s[3 * 33]); o.z = pk2(s[4 * 33], s[5 * 33]); o.w = pk2(s[6 * 33], s[7 * 33]);
        *(u32x4*)(WTrow0 + (size_t)n * ldt + k0 + 8 * c) = o; }
}
DI void convert_weights(const Ctx& C, int layer, int it_lo, int it_hi, int gw, int ngw) {
    LAS float* scr = (LAS float*)(C.lds + C.wave * 8704);
    constexpr int I_IN = 16 * 101, I_GATE = 16 * 128, I_UQ = 6 * 24, I_UKV = 4 * 32, I_GLU = 8 * 16, I_BR = 4 * 8 * 32, I_OUT = 16 * 32, I_FIN = 16 * 176, I_FOUT = 44 * 32;
    constexpr int NITEMS = I_IN + I_GATE + I_UQ + I_UKV + I_GLU + I_BR + I_OUT + I_FIN + I_FOUT;
    (void)NITEMS;
    for (int it = it_lo + gw; it < it_hi; it += ngw) {
        int r = it;
        if (r < I_IN) { const int nb = 101, kb = r / nb, n0 = 32 * (r % nb); transpose_item(C.in[11] + (size_t)layer * 1024 * 3232, 3232, WSP(bf16_t, WT_G1) + (size_t)n0 * 1024, 1024, 64 * kb, n0, scr, C.lane); continue; } r -= I_IN;
        if (r < I_GATE) { const int nb = 128, kb = r / nb, n0 = 32 * (r % nb); transpose_item(C.in[29] + (size_t)layer * 1024 * 4096, 4096, WSP(bf16_t, WT_G1) + (size_t)(ZLD + n0) * 1024, 1024, 64 * kb, n0, scr, C.lane); continue; } r -= I_GATE;
        if (r < I_UQ) { const int nb = 24, kb = r / nb, n0 = 32 * (r % nb); transpose_item(C.in[14] + (size_t)layer * 384 * 768, 768, WSP(bf16_t, WT_UQ) + (size_t)n0 * 384, 384, 64 * kb, n0, scr, C.lane); continue; } r -= I_UQ;
        if (r < I_UKV) { const int nb = 32, kb = r / nb, n0 = 32 * (r % nb); const int h = n0 >> 7, j0 = n0 & 127;
            bf16_t* dst = (j0 < 64) ? WSP(bf16_t, WT_UKN) + (size_t)(h * 64 + j0) * 256 : WSP(bf16_t, WT_UV) + (size_t)(h * 64 + j0 - 64) * 256;
            transpose_item(C.in[15] + (size_t)layer * 256 * 1024, 1024, dst, 256, 64 * kb, n0, scr, C.lane); continue; } r -= I_UKV;
        if (r < I_GLU) { const int nb = 16, kb = r / nb, n0 = 32 * (r % nb); transpose_item(C.in[26] + (size_t)layer * 512 * 512, 512, WSP(bf16_t, WT_GLU) + (size_t)n0 * 512, 512, 64 * kb, n0, scr, C.lane); continue; } r -= I_GLU;
        if (r < I_BR) { const int k = r / 256, rr = r % 256, nb = 32, kb = rr / nb, n0 = 32 * (rr % nb);
            transpose_item(C.in[28] + ((size_t)layer * 4 + k) * 512 * 1024, 1024, WSP(bf16_t, WT_BR) + ((size_t)k * 1024 + n0) * 512, 512, 64 * kb, n0, scr, C.lane); continue; } r -= I_BR;
        if (r < I_OUT) { const int nb = 32, kb = r / nb, n0 = 32 * (r % nb); transpose_item(C.in[31] + (size_t)layer * 1024 * 1024, 1024, WSP(bf16_t, WT_OUT) + (size_t)n0 * 1024, 1024, 64 * kb, n0, scr, C.lane); continue; } r -= I_OUT;
        if (r < I_FIN) { const int nb = 176, kb = r / nb, n0 = 32 * (r % nb);
            const int drow = (n0 < DFF) ? (n0 >> 7) * 256 + (n0 & 127) : ((n0 - DFF) >> 7) * 256 + 128 + ((n0 - DFF) & 127);
            transpose_item(C.in[32] + (size_t)layer * 1024 * 5632, 5632, WSP(bf16_t, WT_FIN) + (size_t)drow * 1024, 1024, 64 * kb, n0, scr, C.lane); continue; } r -= I_FIN;
        { const int nb = 32, kb = r / nb, n0 = 32 * (r % nb); transpose_item(C.in[33] + (size_t)layer * DFF * 1024, 1024, WSP(bf16_t, WT_FOUT) + (size_t)n0 * DFF, DFF, 64 * kb, n0, scr, C.lane); }
    }
}

constexpr int CW_G1_END = 16 * 101 + 16 * 128, CW_GLU_END = CW_G1_END + 6 * 24 + 4 * 32 + 8 * 16, CW_BR_END = CW_GLU_END + 4 * 8 * 32, CW_FIN_END = CW_BR_END + 16 * 32 + 16 * 176, CW_ALL = CW_FIN_END + 44 * 32;
DI void norm_rows(const Ctx& C, int layer, bool first, int which  ) {
    const float* gam = C.in[which ? 8 : 7] + layer * 1024;
    const float* mod = WSP(float, WS_MOD) + (size_t)layer * 3 * 6144;
    bf16_t* xn = WSP(bf16_t, WS_XN);
    for (int r = C.gw; r < MTOK; r += C.NGW) {
        const float* xr = first ? (r < NCTX ? C.in[0] + (size_t)r * 1024 : C.in[1] + (size_t)(r - NCTX) * 1024) : WSP(float, WS_X) + (size_t)r * 1024;
        const float* mv = mod + cond_of(r) * 6144 + which * 3072;
        f32x4 v[4], gg[4], shh[4], scc[4]; float ss = 0.f;
#pragma unroll
        for (int j = 0; j < 4; ++j) { const int c = 4 * C.lane + 256 * j; v[j] = *(const f32x4*)(xr + c); gg[j] = *(const f32x4*)(gam + c); shh[j] = *(const f32x4*)(mv + c); scc[j] = *(const f32x4*)(mv + 1024 + c); }
#pragma unroll
        for (int j = 0; j < 4; ++j) ss += v[j][0] * v[j][0] + v[j][1] * v[j][1] + v[j][2] * v[j][2] + v[j][3] * v[j][3];
        const float rinv = __builtin_amdgcn_rsqf(wave_sum(ss) * (1.f / 1024.f) + EPS);
#pragma unroll
        for (int j = 0; j < 4; ++j) { const int c = 4 * C.lane + 256 * j;
            const f32x4 g = gg[j], sh = shh[j], sc = scc[j];
            f32x4 o;
#pragma unroll
            for (int e = 0; e < 4; ++e) o[e] = v[j][e] * rinv * g[e] * (1.f + sc[e]) + sh[e];
            u32x2 p; p.x = pk2(o[0], o[1]); p.y = pk2(o[2], o[3]); *(u32x2*)(xn + (size_t)r * 1024 + c) = p; }
    }
}

DI void phase0(const Ctx& C) {
    for (int i = C.bid * NTHREADS + C.tid; i < 96 * 1024 / 8; i += C.G * NTHREADS) *(u32x4*)(WSP(bf16_t, WT_G1) + (size_t)3232 * 1024 + (size_t)i * 8) = (u32x4){0u, 0u, 0u, 0u};
    LAS float* sc = (LAS float*)C.lds; LAS float* red = sc + 3072;
    for (int i = C.tid; i < 3072; i += NTHREADS) { const int cd = i >> 10, k = i & 1023; const float v = cd == 0 ? C.in[6][k] : C.in[5][(cd - 1) * 1024 + k]; sc[i] = siluf_(v); }
    __syncthreads();
    for (int job = C.bid; job < 384; job += C.G) {
        const int l = job / 96, col0 = (job % 96) * 64;
        const float* W = C.in[9] + (size_t)l * 1024 * 6144 + col0 + C.lane;
        float a0 = 0.f, a1 = 0.f, a2 = 0.f;
#pragma unroll 8
        for (int kk = 0; kk < 128; ++kk) { const int k = C.wave * 128 + kk; const float w = W[(size_t)k * 6144]; a0 += sc[k] * w; a1 += sc[1024 + k] * w; a2 += sc[2048 + k] * w; }
        red[(C.wave * 3 + 0) * 64 + C.lane] = a0; red[(C.wave * 3 + 1) * 64 + C.lane] = a1; red[(C.wave * 3 + 2) * 64 + C.lane] = a2;
        __syncthreads();
        if (C.wave < 3) { float s = 0.f;
#pragma unroll
            for (int w = 0; w < 8; ++w) s += red[(w * 3 + C.wave) * 64 + C.lane];
            WSP(float, WS_MOD)[((size_t)l * 3 + C.wave) * 6144 + col0 + C.lane] = s + C.in[10][l * 6144 + col0 + C.lane]; }
        __syncthreads();
    }
    const int gt = C.bid * NTHREADS + C.tid, NT = C.G * NTHREADS;
    for (int e = gt; e < 16384; e += NT) {
        const int ldg = e >> 6, p = e & 63;
        const float lr = C.in[18][e], li = C.in[19][e], dt = expf(C.in[20][ldg]);
        const float mag = expf(lr * dt), ar = mag * cosf(li * dt), ai = mag * sinf(li * dt);
        float pr = ar, pi = ai;
#pragma unroll
        for (int s = 0; s < 8; ++s) { const float nr = pr * pr - pi * pi, ni = 2.f * pr * pi; pr = nr; pi = ni; }
        *(f32x4*)(WSP(float, WS_SSMA) + (size_t)e * 4) = (f32x4){ar, ai, pr, pi};
        const float den = lr * lr + li * li;
        const float fr_ = ((ar - 1.f) * lr + ai * li) / den, fi_ = (ai * lr - (ar - 1.f) * li) / den;
        const float* bre = C.in[21] + (size_t)e * 16; const float* bim = C.in[22] + (size_t)e * 16;
        bf16_t* bbr = WSP(bf16_t, WS_BBC) + ((size_t)ldg * 128 + p) * 16; bf16_t* bbi = bbr + 64 * 16;
#pragma unroll
        for (int c = 0; c < 16; c += 2) {
            const float r0 = fr_ * bre[c] - fi_ * bim[c], i0 = fr_ * bim[c] + fi_ * bre[c], r1 = fr_ * bre[c + 1] - fi_ * bim[c + 1], i1 = fr_ * bim[c + 1] + fi_ * bre[c + 1];
            *(unsigned*)(bbr + c) = pk2(r0, r1); *(unsigned*)(bbi + c) = pk2(i0, i1);
        }
        const float* cre = C.in[23] + (size_t)ldg * 16 * 64; const float* cim = C.in[24] + (size_t)ldg * 16 * 64;
        bf16_t* cc = WSP(bf16_t, WS_CCAT) + (size_t)ldg * 16 * 128;
#pragma unroll
        for (int c = 0; c < 16; ++c) *(unsigned*)(cc + c * 128 + 2 * p) = pk2(cre[c * 64 + p], -cim[c * 64 + p]);
    }
    for (int e = gt; e < 2048 * 16; e += NT) {
        const int pos = e >> 4, i = e & 15; const float inv = exp2f(-(float)(i & 7) * (13.287712379549449f / 8.f));
        const float ang = (float)(i < 8 ? (pos >> 6) : (pos & 63)) * inv;
        *(f32x2*)(WSP(float, WS_ROPE) + (size_t)e * 2) = (f32x2){cosf(ang), sinf(ang)};
    }
    for (int ch = gt; ch < 1024 * 512 / 8; ch += NT) {
        const int r = ch >> 6, col0 = (ch & 63) * 8, g = r >> 8, pq = (r >> 7) & 1, m = r & 127; float v[8];
#pragma unroll
        for (int j = 0; j < 8; ++j) { const int col = col0 + j, c = col & 127; const float ph = (float)((m * c) & 127) * (1.f / 128.f);
            const float t = pq ? __builtin_amdgcn_sinf(ph) : __builtin_amdgcn_cosf(ph); v[j] = ((col >> 7) == g) ? t * 0.08838834764831845f : 0.f; }
        *(u32x4*)(WSP(bf16_t, WS_DCH) + (size_t)ch * 8) = (u32x4){pk2(v[0], v[1]), pk2(v[2], v[3]), pk2(v[4], v[5]), pk2(v[6], v[7])};
    }
    for (int ch = gt; ch < 256 * 512 / 8; ch += NT) {
        const int k = ch >> 6, l0 = (ch & 63) * 8; float v[8];
#pragma unroll
        for (int j = 0; j < 8; ++j) { const int lp = l0 + j, l = lp & 255; const float ph = (float)((k * l) & 255) * (1.f / 256.f);
            v[j] = (lp < 256 ? __builtin_amdgcn_cosf(ph) : -__builtin_amdgcn_sinf(ph)) * 0.0625f; }
        *(u32x4*)(WSP(bf16_t, WS_DCTX) + (size_t)ch * 8) = (u32x4){pk2(v[0], v[1]), pk2(v[2], v[3]), pk2(v[4], v[5]), pk2(v[6], v[7])};
    }
    for (int ch = gt; ch < 2048 * 4096 / 8; ch += NT) {
        const int k = ch >> 9, l0 = (ch & 511) * 8; float v[8];
#pragma unroll
        for (int j = 0; j < 8; ++j) { const int lp = l0 + j, l = lp & 2047; const float ph = (float)((k * l) & 2047) * (1.f / 2048.f);
            v[j] = (lp < 2048 ? __builtin_amdgcn_cosf(ph) : -__builtin_amdgcn_sinf(ph)) * 0.02209708691207961f; }
        *(u32x4*)(WSP(bf16_t, WS_DLAT) + (size_t)ch * 8) = (u32x4){pk2(v[0], v[1]), pk2(v[2], v[3]), pk2(v[4], v[5]), pk2(v[6], v[7])};
    }
}

DI void pc_rows(const Ctx& C, int layer) {
    const bf16_t* z = WSP(bf16_t, WS_Z);
    const float* qg = C.in[12] + layer * 384; const float* kvg = C.in[13] + layer * 256; const float* cw = C.in[27] + layer * 3 * 512;
    for (int r = C.gw; r < MKV; r += C.NGW) {
        if (r >= MTOK) {
            const int rr = r - MTOK, b = rr >> 9, pos = rr & 511;
            const f32x4 v = *(const f32x4*)(C.in[2] + (((size_t)b * 4 + layer) * 512 + pos) * 256 + 4 * C.lane);
            u32x2 o; o.x = pk2(v[0], v[1]); o.y = pk2(v[2], v[3]); *(u32x2*)(WSP(bf16_t, WS_CKVN) + (size_t)r * 256 + 4 * C.lane) = o; continue;
        }
        const bf16_t* zr = z + (size_t)r * ZLD;
        unsigned wq[3], wk[2], wkp = 0u; u32x4 ch1, cg1, cgb, ch0 = {0u, 0u, 0u, 0u}, cg0 = {0u, 0u, 0u, 0u}, ch2 = {0u, 0u, 0u, 0u}, cg2 = {0u, 0u, 0u, 0u};
        const int Lr = r < NCTX ? 256 : 2048, lr = r < NCTX ? (r & 255) : ((r - NCTX) & 2047);
        const bool hp = lr > 0, hn = lr < Lr - 1;
#pragma unroll
        for (int j = 0; j < 3; ++j) wq[j] = *(const unsigned*)(zr + OFF_CQ + 2 * C.lane + 128 * j);
#pragma unroll
        for (int j = 0; j < 2; ++j) wk[j] = *(const unsigned*)(zr + OFF_CKV + 2 * C.lane + 128 * j);
        if (r < NCTX && C.lane < 16) wkp = *(const unsigned*)(zr + OFF_KPE + 2 * C.lane);
        { const int c = 8 * C.lane;
            ch1 = *(const u32x4*)(zr + OFF_HIN + c); cg1 = *(const u32x4*)(zr + OFF_GC + c); cgb = *(const u32x4*)(zr + OFF_GB + c);
            if (hp) { ch0 = *(const u32x4*)(zr - ZLD + OFF_HIN + c); cg0 = *(const u32x4*)(zr - ZLD + OFF_GC + c); }
            if (hn) { ch2 = *(const u32x4*)(zr + ZLD + OFF_HIN + c); cg2 = *(const u32x4*)(zr + ZLD + OFF_GC + c); } }
        { unsigned w[3]; float ss = 0.f;
#pragma unroll
          for (int j = 0; j < 3; ++j) { w[j] = wq[j]; const float a = bflo(w[j]), b = bfhi(w[j]); ss += a * a + b * b; }
          const float rinv = __builtin_amdgcn_rsqf(wave_sum(ss) * (1.f / 384.f) + EPS);
#pragma unroll
          for (int j = 0; j < 3; ++j) { const int c = 2 * C.lane + 128 * j; *(unsigned*)(WSP(bf16_t, WS_CQN) + (size_t)r * 384 + c) = pk2(bflo(w[j]) * rinv * qg[c], bfhi(w[j]) * rinv * qg[c + 1]); } }
        { unsigned w[2]; float ss = 0.f;
#pragma unroll
          for (int j = 0; j < 2; ++j) { w[j] = wk[j]; const float a = bflo(w[j]), b = bfhi(w[j]); ss += a * a + b * b; }
          const float rinv = __builtin_amdgcn_rsqf(wave_sum(ss) * (1.f / 256.f) + EPS);
#pragma unroll
          for (int j = 0; j < 2; ++j) { const int c = 2 * C.lane + 128 * j; const float a = bflo(w[j]) * rinv * kvg[c], b = bfhi(w[j]) * rinv * kvg[c + 1];
              *(unsigned*)(WSP(bf16_t, WS_CKVN) + (size_t)r * 256 + c) = pk2(a, b);
              if (r < NCTX) { const int bb = r >> 8, l = r & 255; *(f32x2*)(C.out + OUT_CKV + (((size_t)bb * 4 + layer) * 256 + l) * 256 + c) = (f32x2){a, b}; } }
          if (r < NCTX && C.lane < 16) { const int bb = r >> 8, l = r & 255; const unsigned kp = wkp;
              *(f32x2*)(C.out + OUT_KPE + (((size_t)bb * 4 + layer) * 256 + l) * 32 + 2 * C.lane) = (f32x2){bflo(kp), bfhi(kp)}; } }
        { const int c0 = 8 * C.lane; unsigned ov[4];
#pragma unroll
          for (int j = 0; j < 4; ++j) { const int c = c0 + 2 * j;
              const unsigned h1 = ch1[j], g1 = cg1[j], gb = cgb[j], h0 = ch0[j], g0 = cg0[j], h2 = ch2[j], g2 = cg2[j];
              const float ya = cw[c] * bflo(h0) * bflo(g0) + cw[512 + c] * bflo(h1) * bflo(g1) + cw[1024 + c] * bflo(h2) * bflo(g2);
              const float yb = cw[c + 1] * bfhi(h0) * bfhi(g0) + cw[512 + c + 1] * bfhi(h1) * bfhi(g1) + cw[1024 + c + 1] * bfhi(h2) * bfhi(g2);
              ov[j] = pk2(bflo(gb) * ya, bfhi(gb) * yb); }
          *(u32x4*)(WSP(bf16_t, WS_BR) + ((size_t)3 * MTOK + r) * 512 + c0) = (u32x4){ov[0], ov[1], ov[2], ov[3]}; }
    }
}

template <bool WRITE_Y>
DI void ssm_job(const Ctx& C, int layer, int sb, int d, int g, int jc, LAS unsigned char* wl) {
    const int lane = C.lane, hh = lane >> 5, l31 = lane & 31;
    const int ldg = (layer * 2 + d) * 32 + g;
    const bool lat = sb >= 32;
    const int nchunk = lat ? 8 : 1, chunk = d == 0 ? jc : nchunk - 1 - jc;
    const int tok0 = lat ? NCTX + (sb - 32) * 2048 + chunk * 256 : sb * 256;
    const f32x4 av = *(const f32x4*)(WSP(float, WS_SSMA) + ((size_t)ldg * 64 + lane) * 4);
    const float ar = av[0], ai = av[1];
    float hr = 0.f, hi = 0.f;
    if (lat && WRITE_Y) {
        const float* h0 = C.in[4] + ((((size_t)(sb - 32) * 4 + layer) * 2 + d) * 32 + g) * 128 + lane * 2;
        hr = h0[0]; hi = h0[1];
        const float* cs = WSP(float, WS_CST) + ((((size_t)(sb - 32) * 2 + d) * 32 + g) * 8) * 128 + lane * 2;
        for (int j = 0; j < jc; ++j) { const float nr = av[2] * hr - av[3] * hi + cs[j * 128], ni = av[2] * hi + av[3] * hr + cs[j * 128 + 1]; hr = nr; hi = ni; }
    }
    bf16x8 BB[4];
#pragma unroll
    for (int nb = 0; nb < 4; ++nb) BB[nb] = *(const bf16x8*)(WSP(bf16_t, WS_BBC) + ((size_t)ldg * 128 + nb * 32 + l31) * 16 + 8 * hh);
    bf16x8 CC[4];
    if (WRITE_Y) {
#pragma unroll
        for (int kk = 0; kk < 4; ++kk) CC[kk] = *(const bf16x8*)(WSP(bf16_t, WS_CCAT) + ((size_t)ldg * 16 + (lane & 15)) * 128 + 32 * kk + 8 * (lane >> 4));
    }
    LAS float* Xl = (LAS float*)wl;
    LAS bf16_t* Hl = (LAS bf16_t*)(wl + 8192);
    const bf16_t* z = WSP(bf16_t, WS_Z);
    bf16_t* ydir = WSP(bf16_t, WS_XN) + (size_t)d * MTOK * 512;
    for (int i = 0; i < 8; ++i) {
        const int s = 32 * i + l31, tok = d == 0 ? tok0 + s : tok0 + 255 - s;
        const bf16x8 U = *(const bf16x8*)(z + (size_t)tok * ZLD + g * 16 + 8 * hh);
        f32x16 X[4];
#pragma unroll
        for (int nb = 0; nb < 4; ++nb) { f32x16 zz;
#pragma unroll
            for (int q = 0; q < 16; ++q) zz[q] = 0.f;
            opaque16(zz);
            X[nb] = __builtin_amdgcn_mfma_f32_32x32x16_bf16(U, BB[nb], zz, 0, 0, 0); }
        keep(U); keep(BB[0]); keep(BB[1]); keep(BB[2]); keep(BB[3]);
        asm volatile("s_nop 15\n\ts_nop 15\n\ts_nop 15\n\ts_nop 15" : "+v"(X[0]), "+v"(X[1]), "+v"(X[2]), "+v"(X[3]));
#pragma unroll
        for (int half = 0; half < 2; ++half) {
#pragma unroll
            for (int nb = 0; nb < 4; ++nb)
#pragma unroll
                for (int q = 0; q < 8; ++q) { const int mrow = (q & 3) + 8 * (q >> 2) + 4 * hh;
                    Xl[mrow * 128 + nb * 32 + l31] = X[nb][8 * half + q]; }
#pragma unroll 16
            for (int st = 0; st < 16; ++st) {
                const float xr = Xl[st * 128 + lane], xi = Xl[st * 128 + 64 + lane];
                const float nr = ar * hr - ai * hi + xr, ni = ar * hi + ai * hr + xi; hr = nr; hi = ni;
                if (WRITE_Y) *(LAS unsigned*)(Hl + st * 136 + 2 * lane) = pk2(hr, hi);
            }
            if (WRITE_Y) {
                f32x4 y = {0.f, 0.f, 0.f, 0.f}; opaque4(y);
#pragma unroll
                for (int kk = 0; kk < 4; ++kk) { const bf16x8 hb = *(const LAS bf16x8*)(Hl + (lane & 15) * 136 + 32 * kk + 8 * (lane >> 4));
                    y = __builtin_amdgcn_mfma_f32_16x16x32_bf16(CC[kk], hb, y, 0, 0, 0); keep(hb); keep(CC[kk]); }
                const int s2 = 32 * i + 16 * half + (lane & 15), tok2 = d == 0 ? tok0 + s2 : tok0 + 255 - s2;
                u32x2 o; o.x = pk2(y[0], y[1]); o.y = pk2(y[2], y[3]);
                *(u32x2*)(ydir + (size_t)tok2 * 512 + g * 16 + 4 * (lane >> 4)) = o;
            }
        }
    }
    if (!lat) *(f32x2*)(C.out + OUT_SSM + (((((size_t)sb * 4 + layer) * 2 + d) * 32 + g) * 64 + lane) * 2) = (f32x2){hr, hi};
    else if (!WRITE_Y) *(f32x2*)(WSP(float, WS_CST) + (((((size_t)(sb - 32) * 2 + d) * 32 + g) * 8 + jc) * 64 + lane) * 2) = (f32x2){hr, hi};
}
DI void ssm_phase_a(const Ctx& C, int layer) {
    LAS unsigned char* wl = C.lds + C.wave * 12800;
    for (int j = C.gw; j < 2048 + 896; j += C.NGW) {
        if (j < 2048) { const int sb = j >> 6, d = (j >> 5) & 1, g = j & 31; ssm_job<true>(C, layer, sb, d, g, 0, wl); }
        else { const int q = j - 2048, jc = q % 7, r = q / 7, sb = 32 + (r >> 6), d = (r >> 5) & 1, g = r & 31; ssm_job<false>(C, layer, sb, d, g, jc, wl); }
    }
}
DI void ssm_phase_b(const Ctx& C, int layer, int gw, int ngw) {
    LAS unsigned char* wl = C.lds + C.wave * 12800;
    for (int j = gw; j < 1024; j += ngw) { const int jc = j & 7, r = j >> 3, sb = 32 + (r >> 6), d = (r >> 5) & 1, g = r & 31; ssm_job<true>(C, layer, sb, d, g, jc, wl); }
}
DI void ssm_finish(const Ctx& C, int layer) {
    const bf16_t* y0 = WSP(bf16_t, WS_XN); const bf16_t* y1 = y0 + (size_t)MTOK * 512; const float* dsk = C.in[25] + layer * 512 + 8 * C.lane;
    const f32x4 d0 = *(const f32x4*)dsk, d1 = *(const f32x4*)(dsk + 4);
    for (int r = C.gw; r < MTOK; r += C.NGW) {
        const u32x4 a = *(const u32x4*)(y0 + (size_t)r * 512 + 8 * C.lane), b = *(const u32x4*)(y1 + (size_t)r * 512 + 8 * C.lane), u = *(const u32x4*)(WSP(bf16_t, WS_Z) + (size_t)r * ZLD + 8 * C.lane);
        u32x4 o;
        o.x = pk2(geluf_(bflo(a.x) + bflo(b.x) + bflo(u.x) * d0[0]), geluf_(bfhi(a.x) + bfhi(b.x) + bfhi(u.x) * d0[1]));
        o.y = pk2(geluf_(bflo(a.y) + bflo(b.y) + bflo(u.y) * d0[2]), geluf_(bfhi(a.y) + bfhi(b.y) + bfhi(u.y) * d0[3]));
        o.z = pk2(geluf_(bflo(a.z) + bflo(b.z) + bflo(u.z) * d1[0]), geluf_(bfhi(a.z) + bfhi(b.z) + bfhi(u.z) * d1[1]));
        o.w = pk2(geluf_(bflo(a.w) + bflo(b.w) + bflo(u.w) * d1[2]), geluf_(bfhi(a.w) + bfhi(b.w) + bfhi(u.w) * d1[3]));
        *(u32x4*)(WSP(bf16_t, WS_YPRE) + (size_t)r * 512 + 8 * C.lane) = o;
    }
}

DI void k_post(const Ctx& C, int layer) {
    const float* kg = C.in[17] + layer * 96; const int h = C.lane >> 3, sub = C.lane & 7;
    for (int r = C.gw; r < MKV; r += C.NGW) {
        const u32x4 kn = *(const u32x4*)(WSP(bf16_t, WS_KNOPE) + (size_t)r * 512 + h * 64 + 8 * sub);
        float e[4];
        if (r < MTOK) { const u32x2 kp = *(const u32x2*)(WSP(bf16_t, WS_Z) + (size_t)r * ZLD + OFF_KPE + 4 * sub); e[0] = bflo(kp.x); e[1] = bfhi(kp.x); e[2] = bflo(kp.y); e[3] = bfhi(kp.y); }
        else { const int rr = r - MTOK, b = rr >> 9, pos = rr & 511; const f32x4 kp = *(const f32x4*)(C.in[3] + (((size_t)b * 4 + layer) * 512 + pos) * 32 + 4 * sub); e[0] = kp[0]; e[1] = kp[1]; e[2] = kp[2]; e[3] = kp[3]; }
        const bool own = r >= NCTX && r < MTOK;
        f32x4 cs = {1.f, 0.f, 1.f, 0.f};
        if (own) cs = *(const f32x4*)(WSP(float, WS_ROPE) + ((size_t)((r - NCTX) & 2047) * 16 + 2 * sub) * 2);
        float v[8] = {bflo(kn.x), bfhi(kn.x), bflo(kn.y), bfhi(kn.y), bflo(kn.z), bfhi(kn.z), bflo(kn.w), bfhi(kn.w)};
        float ss = e[0] * e[0] + e[1] * e[1] + e[2] * e[2] + e[3] * e[3];
#pragma unroll
        for (int j = 0; j < 8; ++j) ss += v[j] * v[j];
        ss += __shfl_xor(ss, 1); ss += __shfl_xor(ss, 2); ss += __shfl_xor(ss, 4);
        const float rinv = __builtin_amdgcn_rsqf(ss * (1.f / 96.f) + EPS);
#pragma unroll
        for (int j = 0; j < 8; ++j) v[j] *= rinv * kg[8 * sub + j];
#pragma unroll
        for (int j = 0; j < 4; ++j) e[j] *= rinv * kg[64 + 4 * sub + j];
        if (own) {
            const float a0 = e[0] * cs[0] - e[1] * cs[1], b0 = e[0] * cs[1] + e[1] * cs[0], a1 = e[2] * cs[2] - e[3] * cs[3], b1 = e[2] * cs[3] + e[3] * cs[2];
            e[0] = a0; e[1] = b0; e[2] = a1; e[3] = b1; }
        bf16_t* kr = WSP(bf16_t, WS_K) + (size_t)r * 768 + h * 96;
        *(u32x4*)(kr + 8 * sub) = (u32x4){pk2(v[0], v[1]), pk2(v[2], v[3]), pk2(v[4], v[5]), pk2(v[6], v[7])};
        *(u32x2*)(kr + 64 + 4 * sub) = (u32x2){pk2(e[0], e[1]), pk2(e[2], e[3])};
    }
}

DI void pe_rows(const Ctx& C, int layer) {
    const bf16_t* y0 = WSP(bf16_t, WS_XN); const bf16_t* y1 = y0 + (size_t)MTOK * 512; const float* dsk = C.in[25] + layer * 512 + 8 * C.lane;
    const f32x4 d0 = *(const f32x4*)dsk, d1 = *(const f32x4*)(dsk + 4);
    const float* kg = C.in[17] + layer * 96; const int h = C.lane >> 3, sub = C.lane & 7;
    for (int r = C.gw; r < MKV; r += C.NGW) {
        const u32x4 kn = *(const u32x4*)(WSP(bf16_t, WS_KNOPE) + (size_t)r * 512 + h * 64 + 8 * sub);
        float e[4];
        if (r < MTOK) { const u32x2 kp = *(const u32x2*)(WSP(bf16_t, WS_Z) + (size_t)r * ZLD + OFF_KPE + 4 * sub); e[0] = bflo(kp.x); e[1] = bfhi(kp.x); e[2] = bflo(kp.y); e[3] = bfhi(kp.y); }
        else { const int rr = r - MTOK, b = rr >> 9, pos = rr & 511; const f32x4 kp = *(const f32x4*)(C.in[3] + (((size_t)b * 4 + layer) * 512 + pos) * 32 + 4 * sub); e[0] = kp[0]; e[1] = kp[1]; e[2] = kp[2]; e[3] = kp[3]; }
        const bool own = r >= NCTX && r < MTOK;
        f32x4 cs = {1.f, 0.f, 1.f, 0.f};
        if (own) cs = *(const f32x4*)(WSP(float, WS_ROPE) + ((size_t)((r - NCTX) & 2047) * 16 + 2 * sub) * 2);
        u32x4 ya = {0u, 0u, 0u, 0u}, yb = ya, yu = ya, fa = ya, fb = ya;
        if (r < MTOK) { ya = *(const u32x4*)(y0 + (size_t)r * 512 + 8 * C.lane); yb = *(const u32x4*)(y1 + (size_t)r * 512 + 8 * C.lane); yu = *(const u32x4*)(WSP(bf16_t, WS_Z) + (size_t)r * ZLD + 8 * C.lane); }
        if (own) { fa = *(const u32x4*)(WSP(bf16_t, WS_BR) + ((size_t)1 * MTOK + r) * 512 + 8 * C.lane); fb = *(const u32x4*)(WSP(bf16_t, WS_FT) + (size_t)(r - NCTX) * 512 + 8 * C.lane); }
        float v[8] = {bflo(kn.x), bfhi(kn.x), bflo(kn.y), bfhi(kn.y), bflo(kn.z), bfhi(kn.z), bflo(kn.w), bfhi(kn.w)};
        float ss = e[0] * e[0] + e[1] * e[1] + e[2] * e[2] + e[3] * e[3];
#pragma unroll
        for (int j = 0; j < 8; ++j) ss += v[j] * v[j];
        ss += __shfl_xor(ss, 1); ss += __shfl_xor(ss, 2); ss += __shfl_xor(ss, 4);
        const float rinv = __builtin_amdgcn_rsqf(ss * (1.f / 96.f) + EPS);
#pragma unroll
        for (int j = 0; j < 8; ++j) v[j] *= rinv * kg[8 * sub + j];
#pragma unroll
        for (int j = 0; j < 4; ++j) e[j] *= rinv * kg[64 + 4 * sub + j];
        if (own) {
            const float a0 = e[0] * cs[0] - e[1] * cs[1], b0 = e[0] * cs[1] + e[1] * cs[0], a1 = e[2] * cs[2] - e[3] * cs[3], b1 = e[2] * cs[3] + e[3] * cs[2];
            e[0] = a0; e[1] = b0; e[2] = a1; e[3] = b1; }
        bf16_t* kr = WSP(bf16_t, WS_K) + (size_t)r * 768 + h * 96;
        *(u32x4*)(kr + 8 * sub) = (u32x4){pk2(v[0], v[1]), pk2(v[2], v[3]), pk2(v[4], v[5]), pk2(v[6], v[7])};
        *(u32x2*)(kr + 64 + 4 * sub) = (u32x2){pk2(e[0], e[1]), pk2(e[2], e[3])};
        if (r < MTOK) {
            u32x4 o;
            o.x = pk2(geluf_(bflo(ya.x) + bflo(yb.x) + bflo(yu.x) * d0[0]), geluf_(bfhi(ya.x) + bfhi(yb.x) + bfhi(yu.x) * d0[1]));
            o.y = pk2(geluf_(bflo(ya.y) + bflo(yb.y) + bflo(yu.y) * d0[2]), geluf_(bfhi(ya.y) + bfhi(yb.y) + bfhi(yu.y) * d0[3]));
            o.z = pk2(geluf_(bflo(ya.z) + bflo(yb.z) + bflo(yu.z) * d1[0]), geluf_(bfhi(ya.z) + bfhi(yb.z) + bfhi(yu.z) * d1[1]));
            o.w = pk2(geluf_(bflo(ya.w) + bflo(yb.w) + bflo(yu.w) * d1[2]), geluf_(bfhi(ya.w) + bfhi(yb.w) + bfhi(yu.w) * d1[3]));
            *(u32x4*)(WSP(bf16_t, WS_YPRE) + (size_t)r * 512 + 8 * C.lane) = o;
        }
        if (own) {
            u32x4 o; o.x = pk2(bflo(fa.x) + bflo(fb.x), bfhi(fa.x) + bfhi(fb.x)); o.y = pk2(bflo(fa.y) + bflo(fb.y), bfhi(fa.y) + bfhi(fb.y));
            o.z = pk2(bflo(fa.z) + bflo(fb.z), bfhi(fa.z) + bfhi(fb.z)); o.w = pk2(bflo(fa.w) + bflo(fb.w), bfhi(fa.w) + bfhi(fb.w));
            *(u32x4*)(WSP(bf16_t, WS_BR) + ((size_t)1 * MTOK + r) * 512 + 8 * C.lane) = o;
        }
    }
}


struct KVF { bf16x8 k[6]; bf16x8 v[2][2]; };
DI int attn_row0(bool lat, int b, int t) { return lat ? (t < 64 ? NCTX + b * 2048 + 32 * t : MTOK + b * 512 + 32 * (t - 64)) : b * 256 + 32 * t; }
DI void attn_load(const bf16_t* Kb, const bf16_t* Vb, int kr0, int l31, int hh, KVF& f) {
    const bf16_t* kp = Kb + (size_t)(kr0 + l31) * 768;
#pragma unroll
    for (int kk = 0; kk < 6; ++kk) f.k[kk] = *(const bf16x8*)(kp + 16 * kk);
#pragma unroll
    for (int db = 0; db < 2; ++db)
#pragma unroll
        for (int s = 0; s < 2; ++s) { const bf16_t* vp = Vb + (size_t)db * 32 * MKV + kr0 + 16 * s + 4 * hh;
            const u32x2 lo = *(const u32x2*)vp, hi2 = *(const u32x2*)(vp + 8); u32x4 w = {lo.x, lo.y, hi2.x, hi2.y}; f.v[db][s] = __builtin_bit_cast(bf16x8, w); }
}
DI void attn_tile(const KVF& f, const bf16x8 (&Q)[6], f32x16& O0, f32x16& O1, float& mrun, float& lrun) {
    f32x16 S;
#pragma unroll
    for (int q = 0; q < 16; ++q) S[q] = 0.f;
    opaque16(S);
#pragma unroll
    for (int kk = 0; kk < 6; ++kk) S = __builtin_amdgcn_mfma_f32_32x32x16_bf16(f.k[kk], Q[kk], S, 0, 0, 0);
    float mt = S[0];
#pragma unroll
    for (int q = 1; q < 16; ++q) mt = fmaxf(mt, S[q]);
    mt = fmaxf(mt, __shfl_xor(mt, 32));
    const float mnew = fmaxf(mrun, mt), alpha = __builtin_amdgcn_exp2f(mrun - mnew); mrun = mnew;
    float ls = 0.f;
#pragma unroll
    for (int q = 0; q < 16; ++q) { S[q] = __builtin_amdgcn_exp2f(S[q] - mnew); ls += S[q]; }
    lrun = lrun * alpha + ls;
#pragma unroll
    for (int q = 0; q < 16; ++q) { O0[q] *= alpha; O1[q] *= alpha; }
#pragma unroll
    for (int s = 0; s < 2; ++s) { u32x4 p = {pk2(S[8 * s], S[8 * s + 1]), pk2(S[8 * s + 2], S[8 * s + 3]), pk2(S[8 * s + 4], S[8 * s + 5]), pk2(S[8 * s + 6], S[8 * s + 7])};
        const bf16x8 pf = __builtin_bit_cast(bf16x8, p);
        O0 = __builtin_amdgcn_mfma_f32_32x32x16_bf16(f.v[0][s], pf, O0, 0, 0, 0);
        O1 = __builtin_amdgcn_mfma_f32_32x32x16_bf16(f.v[1][s], pf, O1, 0, 0, 0); }
}
DI void attn_q(const Ctx& C, int layer, bool lat, int q0, int qt, int h, bf16x8 (&Q)[6]) {
    const int lane = C.lane, hh = lane >> 5, l31 = lane & 31;
    const float* qg = C.in[16] + layer * 96;
    const bf16_t* qr = WSP(bf16_t, WS_QRAW) + (size_t)(q0 + l31) * 768 + h * 96 + 8 * hh;
    float v[6][8]; float ss = 0.f;
#pragma unroll
    for (int kk = 0; kk < 6; ++kk) { const u32x4 w = *(const u32x4*)(qr + 16 * kk);
        v[kk][0] = bflo(w.x); v[kk][1] = bfhi(w.x); v[kk][2] = bflo(w.y); v[kk][3] = bfhi(w.y); v[kk][4] = bflo(w.z); v[kk][5] = bfhi(w.z); v[kk][6] = bflo(w.w); v[kk][7] = bfhi(w.w);
#pragma unroll
        for (int j = 0; j < 8; ++j) ss += v[kk][j] * v[kk][j]; }
    ss += __shfl_xor(ss, 32);
    const float rinv = __builtin_amdgcn_rsqf(ss * (1.f / 96.f) + EPS) * (0.10206207261596575f * 1.4426950408889634f);
#pragma unroll
    for (int kk = 0; kk < 6; ++kk)
#pragma unroll
        for (int j = 0; j < 8; ++j) v[kk][j] *= rinv * qg[16 * kk + 8 * hh + j];
    if (lat) { const int pos = qt * 32 + l31;
#pragma unroll
        for (int kk = 4; kk < 6; ++kk) { const float* cs = WSP(float, WS_ROPE) + ((size_t)pos * 16 + 8 * (kk - 4) + 4 * hh) * 2;
#pragma unroll
            for (int pr = 0; pr < 4; ++pr) { const float c = cs[2 * pr], s = cs[2 * pr + 1], xe = v[kk][2 * pr], xo = v[kk][2 * pr + 1]; v[kk][2 * pr] = xe * c - xo * s; v[kk][2 * pr + 1] = xe * s + xo * c; } } }
#pragma unroll
    for (int kk = 0; kk < 6; ++kk) { u32x4 p = {pk2(v[kk][0], v[kk][1]), pk2(v[kk][2], v[kk][3]), pk2(v[kk][4], v[kk][5]), pk2(v[kk][6], v[kk][7])}; Q[kk] = __builtin_bit_cast(bf16x8, p); }
}
constexpr int ATT_KB = 32 * 208, ATT_BUF = ATT_KB + 64 * 80, ATT_GRP = 2 * ATT_BUF, ATT_PART_OFF = 49152;
DI void attn_stage_load(const Ctx& C, bool lat, int b, int h, int t, int tg, u32x4 (&r)[3]) {
    const int kr0 = attn_row0(lat, b, t);
    { const int row = tg / 12, col = tg % 12; r[0] = *(const u32x4*)(WSP(bf16_t, WS_K) + (size_t)(kr0 + row) * 768 + h * 96 + col * 8); }
    if (tg < 128) { const int c = tg + 256, row = c / 12, col = c % 12; r[1] = *(const u32x4*)(WSP(bf16_t, WS_K) + (size_t)(kr0 + row) * 768 + h * 96 + col * 8); }
    { const int row = tg >> 2, col = tg & 3; r[2] = *(const u32x4*)(WSP(bf16_t, WS_VT) + (size_t)(h * 64 + row) * MKV + kr0 + col * 8); }
}
DI void attn_stage_store(LAS unsigned char* buf, int tg, const u32x4 (&r)[3]) {
    { const int row = tg / 12, col = tg % 12; *(LAS u32x4*)(buf + row * 208 + col * 16) = r[0]; }
    if (tg < 128) { const int c = tg + 256, row = c / 12, col = c % 12; *(LAS u32x4*)(buf + row * 208 + col * 16) = r[1]; }
    { const int row = tg >> 2, col = tg & 3; *(LAS u32x4*)(buf + ATT_KB + row * 80 + col * 16) = r[2]; }
}
DI void attn_frags(const LAS unsigned char* buf, int l31, int hh, KVF& f) {
#pragma unroll
    for (int kk = 0; kk < 6; ++kk) f.k[kk] = *(const LAS bf16x8*)(buf + l31 * 208 + 32 * kk + 16 * hh);
#pragma unroll
    for (int db = 0; db < 2; ++db)
#pragma unroll
        for (int s = 0; s < 2; ++s) { const LAS unsigned char* vp = buf + ATT_KB + (32 * db + l31) * 80 + 32 * s + 8 * hh;
            const u32x2 lo = *(const LAS u32x2*)vp, hi2 = *(const LAS u32x2*)(vp + 16); u32x4 w = {lo.x, lo.y, hi2.x, hi2.y}; f.v[db][s] = __builtin_bit_cast(bf16x8, w); }
}
DI void attn_run(const Ctx& C, bool lat, int b, int h, int t0, int nt, const bf16x8 (&Q)[6], f32x16& O0, f32x16& O1, float& mrun, float& lrun) {
    const int lane = C.lane, hh = lane >> 5, l31 = lane & 31, tg = C.tid & 255;
    LAS unsigned char* gbuf = C.lds + (C.wave >> 2) * ATT_GRP;
    u32x4 r[3];
    attn_stage_load(C, lat, b, h, t0, tg, r); attn_stage_store(gbuf, tg, r);
    __syncthreads();
    for (int i = 0; i < nt; ++i) {
        if (i + 1 < nt) attn_stage_load(C, lat, b, h, t0 + i + 1, tg, r);
        KVF f; attn_frags(gbuf + (i & 1) * ATT_BUF, l31, hh, f);
        attn_tile(f, Q, O0, O1, mrun, lrun);
        if (i + 1 < nt) attn_stage_store(gbuf + ((i + 1) & 1) * ATT_BUF, tg, r);
        __syncthreads();
    }
}
DI void attn_store(const Ctx& C, int q0, int h, const f32x16& O0, const f32x16& O1, float lsum) {
    const int lane = C.lane, hh = lane >> 5, l31 = lane & 31;
    const float il = 1.f / lsum;
    bf16_t* op = WSP(bf16_t, WS_BR) + ((size_t)2 * MTOK + q0 + l31) * 512 + h * 64 + 4 * hh;
#pragma unroll
    for (int qd = 0; qd < 4; ++qd) {
        *(u32x2*)(op + 8 * qd) = (u32x2){pk2(O0[4 * qd] * il, O0[4 * qd + 1] * il), pk2(O0[4 * qd + 2] * il, O0[4 * qd + 3] * il)};
        *(u32x2*)(op + 32 + 8 * qd) = (u32x2){pk2(O1[4 * qd] * il, O1[4 * qd + 1] * il), pk2(O1[4 * qd + 2] * il, O1[4 * qd + 3] * il)};
    }
}
DI void attn_phase(const Ctx& C, int layer) {
    LAS float* part = (LAS float*)(C.lds + ATT_PART_OFF) + (size_t)(C.wave & 3) * (34 * 64);
    const int half = C.wave >> 2;
    for (int it4 = C.bid; it4 < 256; it4 += C.G) {
        const int item = it4 * 4 + (C.wave & 3), qt = item & 63, h = (item >> 6) & 7, b = item >> 9, q0 = NCTX + b * 2048 + qt * 32;
        bf16x8 Q[6]; attn_q(C, layer, true, q0, qt, h, Q);
        f32x16 O0, O1;
#pragma unroll
        for (int q = 0; q < 16; ++q) { O0[q] = 0.f; O1[q] = 0.f; }
        float mrun = -1e30f, lrun = 0.f;
        attn_run(C, true, b, h, half * 40, 40, Q, O0, O1, mrun, lrun);
        if (half == 1) {
#pragma unroll
            for (int q = 0; q < 16; ++q) { part[q * 64 + C.lane] = O0[q]; part[(16 + q) * 64 + C.lane] = O1[q]; }
            part[32 * 64 + C.lane] = mrun; part[33 * 64 + C.lane] = lrun;
        }
        __syncthreads();
        if (half == 0) {
            const float m1 = part[32 * 64 + C.lane], l1 = part[33 * 64 + C.lane];
            const float m = fmaxf(mrun, m1), a0 = __builtin_amdgcn_exp2f(mrun - m), a1 = __builtin_amdgcn_exp2f(m1 - m);
#pragma unroll
            for (int q = 0; q < 16; ++q) { O0[q] = O0[q] * a0 + part[q * 64 + C.lane] * a1; O1[q] = O1[q] * a0 + part[(16 + q) * 64 + C.lane] * a1; }
            float lsum = lrun * a0 + l1 * a1; lsum += __shfl_xor(lsum, 32);
            attn_store(C, q0, h, O0, O1, lsum);
        }
        __syncthreads();
    }
    for (int it = C.bid; it < 256; it += C.G) {
        const int h = it & 7, b = it >> 3, qt = C.wave, q0 = b * 256 + qt * 32;
        bf16x8 Q[6]; attn_q(C, layer, false, q0, qt, h, Q);
        f32x16 O0, O1;
#pragma unroll
        for (int q = 0; q < 16; ++q) { O0[q] = 0.f; O1[q] = 0.f; }
        float mrun = -1e30f, lrun = 0.f;
        attn_run(C, false, b, h, 0, 8, Q, O0, O1, mrun, lrun);
        float lsum = lrun + __shfl_xor(lrun, 32);
        attn_store(C, q0, h, O0, O1, lsum);
    }
}

constexpr int PH_PER_LAYER = 11, N_PHASES = 1 + NLAYER * PH_PER_LAYER;

DI void set_sched(pg8::Sched& S, const void* A, const void* B, int lda, int ldb, int K, int nM, int nN, int nZ, int kind, size_t azs, size_t bzs) {
    S.A = (const char*)A; S.B = (const char*)B; S.azs = azs; S.bzs = bzs; S.lda = lda; S.ldb = ldb; S.K = K; S.nM = nM; S.nN = nN; S.nZ = nZ; S.kind = kind;
}
DI void set_epi(Epi& E, int mode, int perm, void* O, int ldc, size_t zstride, void* O2, const void* X0, const void* X1) {
    E.mode = mode; E.perm = perm; E.O = O; E.ldc = ldc; E.zstride = zstride; E.O2 = O2; E.X0 = X0; E.X1 = X1;
}
#define RUN_GEMM(SCHED_ARGS, EPI_ARGS) do { pg8::Sched S; S.G = C.G; S.c = C.bid; set_sched SCHED_ARGS; Epi E; set_epi EPI_ARGS; pg8::gemm_phase<Epi>(C.lds, S, E); } while (0)
#define RUN_GEMM_ON(GX, CX, SCHED_ARGS, EPI_ARGS) do { pg8::Sched S; S.G = (GX); S.c = (CX); set_sched SCHED_ARGS; Epi E; set_epi EPI_ARGS; pg8::gemm_phase<Epi>(C.lds, S, E); } while (0)
DI void run_phase(const Ctx& C, int ph) {
    if (ph == 0) { phase0(C); __syncthreads(); convert_weights(C, 0, 0, CW_ALL, C.gw, C.NGW); return; }
    const int layer = (ph - 1) / PH_PER_LAYER, sub = (ph - 1) % PH_PER_LAYER;
    const float* mod = WSP(float, WS_MOD) + (size_t)layer * 3 * 6144;
    switch (sub) {
    case 0:
        if (layer > 0) convert_weights(C, layer, C.G > 192 ? CW_FIN_END : 0, CW_ALL, C.gw, C.NGW);
        norm_rows(C, layer, layer == 0, 0); break;
    case 1:
        RUN_GEMM((S, WSP(bf16_t, WS_XN), WSP(bf16_t, WT_G1), 1024, 1024, 1024, 48, 29, 1, 0, 0, 0),
                 (E, M_G1, 1, WSP(bf16_t, WS_Z), 0, 0, WSP(bf16_t, WS_GATES), C.in[30] + layer * 4096, nullptr)); break;
    case 2:
        RUN_GEMM((S, WSP(bf16_t, WS_DCH), WSP(bf16_t, WS_Z) + OFF_FFT, 512, ZLD, 512, 4, 48, 1, 0, 0, 0), (E, M_FFT1, 1, WSP(bf16_t, WS_PQT), 0, 0, nullptr, nullptr, nullptr));
        pc_rows(C, layer); ssm_phase_a(C, layer); break;
    case 3: {
        const int NB = 64, GF = C.G - NB, cf = C.bid - NB;
        if (C.bid < NB || GF <= 0) {
            const int sh = (GF > 0 && C.bid >= 32) ? 1 : 0;
            for (int pass = 0; pass < (GF > 0 ? 1 : 2); ++pass) {
                const int s2 = GF > 0 ? sh : pass;
                RUN_GEMM_ON(GF > 0 ? 32 : C.G, GF > 0 ? C.bid - 32 * sh : C.bid,
                            (S, WSP(bf16_t, WS_DLAT) + s2 * 2048, WSP(bf16_t, WS_PQT) + PQT_LAT_EL + s2 * 2048, 4096, 8192, 2048, 8, 2, 2, 1, 0, (size_t)4096 * 2),
                            (E, M_BF16, 1, s2 ? WSP(bf16_t, WS_FT) : WSP(bf16_t, WS_BR) + ((size_t)1 * MTOK + NCTX) * 512, 512, (size_t)2048 * 512, nullptr, nullptr, nullptr));
            }
        }
        if (C.bid >= NB || GF <= 0) {
            const int gq = GF > 0 ? GF : C.G, c0 = GF > 0 ? cf : C.bid;
            RUN_GEMM_ON(gq, c0, (S, WSP(bf16_t, WS_CQN), WSP(bf16_t, WT_UQ), 384, 384, 384, 48, 3, 1, 0, 0, 0), (E, M_BF16, 1, WSP(bf16_t, WS_QRAW), 768, 0, nullptr, nullptr, nullptr));
            RUN_GEMM_ON(gq, (c0 + gq - 144 % gq) % gq, (S, WSP(bf16_t, WS_CKVN), WSP(bf16_t, WT_UKN), 256, 256, 256, 52, 2, 1, 0, 0, 0), (E, M_BF16, 1, WSP(bf16_t, WS_KNOPE), 512, 0, nullptr, nullptr, nullptr));
            RUN_GEMM_ON(gq, (c0 + 2 * gq - (144 + 104) % gq) % gq, (S, WSP(bf16_t, WT_UV), WSP(bf16_t, WS_CKVN), 256, 256, 256, 2, 52, 1, 0, 0, 0), (E, M_BF16, 1, WSP(bf16_t, WS_VT), MKV, 0, nullptr, nullptr, nullptr));
            RUN_GEMM_ON(gq, (c0 + 2 * gq - (144 + 208) % gq) % gq, (S, WSP(bf16_t, WS_DCTX), WSP(bf16_t, WS_PQT), 512, 16384, 512, 1, 2, 32, 1, 0, (size_t)512 * 2),
                        (E, M_BF16, 1, WSP(bf16_t, WS_BR) + (size_t)1 * MTOK * 512, 512, (size_t)256 * 512, nullptr, nullptr, nullptr));
            ssm_phase_b(C, layer, c0 * NWAVES + C.wave, gq * NWAVES);
        }
        break; }
    case 4:
        pe_rows(C, layer); break;
    case 5:
        attn_phase(C, layer);
        __syncthreads();
        RUN_GEMM((S, WSP(bf16_t, WS_YPRE), WSP(bf16_t, WT_GLU), 512, 512, 512, 48, 2, 1, 0, 0, 0), (E, M_GLU, 1, WSP(bf16_t, WS_BR), 0, 0, nullptr, WSP(bf16_t, WS_YPRE), nullptr)); break;
    case 6:
        RUN_GEMM((S, WSP(bf16_t, WS_BR), WSP(bf16_t, WT_BR), 512, 512, 512, 48, 4, 4, 2, (size_t)MTOK * 512 * 2, (size_t)1024 * 512 * 2),
                 (E, M_BRANCH, 1, WSP(bf16_t, WS_Z), 0, 0, WSP(bf16_t, WS_XN), WSP(bf16_t, WS_GATES), nullptr));
        if (C.G > 192 && C.bid >= 192 && layer + 1 < NLAYER) convert_weights(C, layer + 1, 0, CW_GLU_END, (C.bid - 192) * NWAVES + C.wave, (C.G - 192) * NWAVES);
        break;
    case 7:
        RUN_GEMM((S, WSP(bf16_t, WS_XN), WSP(bf16_t, WT_OUT), 1024, 1024, 1024, 48, 4, 1, 0, 0, 0),
                 (E, M_RES, 0, WSP(float, WS_X), 0, 0, (void*)(mod + 2048), layer == 0 ? C.in[0] : WSP(float, WS_X), layer == 0 ? C.in[1] : WSP(float, WS_X) + (size_t)NCTX * 1024));
        if (C.G > 192 && C.bid >= 192 && layer + 1 < NLAYER) convert_weights(C, layer + 1, CW_GLU_END, CW_BR_END, (C.bid - 192) * NWAVES + C.wave, (C.G - 192) * NWAVES);
        break;
    case 8:
        norm_rows(C, layer, false, 1); break;
    case 9:
        RUN_GEMM((S, WSP(bf16_t, WS_XN), WSP(bf16_t, WT_FIN), 1024, 1024, 1024, 48, 22, 1, 0, 0, 0), (E, M_SWIGLU, 1, WSP(bf16_t, WS_Z), 0, 0, nullptr, nullptr, nullptr)); break;
    case 10:
        RUN_GEMM((S, WSP(bf16_t, WS_Z), WSP(bf16_t, WT_FOUT), DFF, DFF, DFF, 48, 4, 1, 0, 0, 0),
                 (E, M_RES, 0, layer == NLAYER - 1 ? C.out : WSP(float, WS_X), 0, 0, (void*)(mod + 5120), WSP(float, WS_X), WSP(float, WS_X) + (size_t)NCTX * 1024));
        if (C.G > 192 && C.bid >= 192 && layer + 1 < NLAYER) convert_weights(C, layer + 1, CW_BR_END, CW_FIN_END, (C.bid - 192) * NWAVES + C.wave, (C.G - 192) * NWAVES);
        break;
    }
}

#define XB_TMO      128
#define XB_XCNT(j)  (256  + 64 * (j))
#define XB_XSUB(j)  (1280 + 64 * (j))
#define XB_XGEN(j)  (2304 + 64 * (j))
#define XB_TOP      3328
#define XB_TOPGEN   3392
#define XCD_BAR_WORDS 3456
#define XB_SPIN_CAP (1u << 18)

__device__ __forceinline__ unsigned xb_ld(unsigned* p)              { return __hip_atomic_load(p, __ATOMIC_RELAXED, __HIP_MEMORY_SCOPE_AGENT); }
__device__ __forceinline__ unsigned xb_add(unsigned* p, unsigned v) { return __hip_atomic_fetch_add(p, v, __ATOMIC_RELAXED, __HIP_MEMORY_SCOPE_AGENT); }
__device__ __forceinline__ unsigned xb_xcc_id() { return (unsigned)__builtin_amdgcn_s_getreg((3 << 11) | 20) & 0xFu; }
#define XB_SPIN(cond, bar) do { unsigned _sp = 0; while (cond) { __builtin_amdgcn_s_sleep(1); \
    if ((++_sp & 255u) == 0u) { if (xb_ld(&(bar)[XB_TMO])) break; if (_sp > XB_SPIN_CAP) { atomicAdd(&(bar)[XB_TMO], 1u); break; } } } } while (0)

struct XcdBarrier {
    unsigned* bar; unsigned x;
    volatile LAS unsigned* st;
};

__device__ __forceinline__ XcdBarrier xcd_barrier_post(unsigned* bar, volatile LAS unsigned* st) {
    XcdBarrier b; b.bar = bar; b.x = xb_xcc_id(); b.st = st;
    if (threadIdx.x == 0) (void)xb_add(&bar[XB_XCNT(b.x)], 1u);
    return b;
}
__device__ __forceinline__ void xcd_barrier_complete(unsigned* bar, unsigned x, unsigned& nloc, unsigned& nx) {
    const unsigned G = gridDim.x * gridDim.y * gridDim.z;
    unsigned sum, cnt, mine, sp = 0u;
    for (;;) {
        sum = 0u; cnt = 0u; mine = 0u;
#pragma unroll
        for (unsigned j = 0; j < 16; ++j) { const unsigned c = xb_ld(&bar[XB_XCNT(j)]); sum += c; cnt += (c > 0u) ? 1u : 0u; mine = (j == x) ? c : mine; }
        if (sum == G) break;
        __builtin_amdgcn_s_sleep(1);
        if ((++sp & 255u) == 0u) { if (xb_ld(&bar[XB_TMO])) break; if (sp > XB_SPIN_CAP) { atomicAdd(&bar[XB_TMO], 1u); break; } }
    }
    nloc = mine > 0u ? mine : 1u; nx = cnt > 0u ? cnt : 1u;
}

__device__ __forceinline__ void xcd_barrier(const XcdBarrier& b) {
    asm volatile("s_waitcnt vmcnt(0)" ::: "memory");
    __syncthreads();
    if (threadIdx.x == 0) {
        unsigned* bar = b.bar;
        __builtin_amdgcn_s_waitcnt(0);
        unsigned nloc = b.st[0], nx = b.st[1];
        if (nloc == 0u) { xcd_barrier_complete(bar, b.x, nloc, nx); b.st[0] = nloc; b.st[1] = nx; }
        const unsigned old = xb_add(&bar[XB_XSUB(b.x)], 1u);
        const unsigned gen = old / nloc;
        if (old + 1u == (gen + 1u) * nloc) {
            __builtin_amdgcn_fence(__ATOMIC_RELEASE, "agent");
            asm volatile("s_waitcnt vmcnt(0)" ::: "memory");
            const unsigned og = xb_add(&bar[XB_TOP], 1u);
            const unsigned tg = og / nx;
            if (og + 1u == (tg + 1u) * nx) xb_add(&bar[XB_TOPGEN], 1u);
            else XB_SPIN(xb_ld(&bar[XB_TOPGEN]) == tg, bar);
            __builtin_amdgcn_fence(__ATOMIC_ACQUIRE, "agent");
            xb_add(&bar[XB_XGEN(b.x)], 1u);
            asm volatile("s_waitcnt vmcnt(0)" ::: "memory");
        } else {
            XB_SPIN(xb_ld(&bar[XB_XGEN(b.x)]) == gen, bar);
            __builtin_amdgcn_fence(__ATOMIC_ACQUIRE, "agent");
            asm volatile("s_waitcnt vmcnt(0)" ::: "memory");
        }
    }
    __syncthreads();
}

__global__ void __launch_bounds__(NTHREADS, 2) mega_fwd(Args args) {
    extern __shared__ __attribute__((aligned(16))) unsigned char lds_raw[];
    Ctx C; C.in = args.in; C.out = args.out; C.ws = args.ws; C.lds = (LAS unsigned char*)lds_raw;
    cg::grid_group grid = cg::this_grid();
    volatile LAS unsigned* bst = (volatile LAS unsigned*)((LAS unsigned char*)lds_raw + 131072);
    if (threadIdx.x < 4) bst[threadIdx.x] = 0u;
    __syncthreads();
    if (args.ph_lo < 0) grid.sync();
    XcdBarrier xbar = xcd_barrier_post((unsigned*)(args.ws + WS_BAR), bst);
    for (int ph = args.ph_lo; ph < args.ph_hi; ++ph) {
        int tid = threadIdx.x; asm volatile("" : "+v"(tid));
        C.tid = tid; C.lane = C.tid & 63; C.wave = __builtin_amdgcn_readfirstlane(C.tid >> 6); C.G = gridDim.x; C.bid = blockIdx.x;
        C.gw = C.bid * NWAVES + C.wave; C.NGW = C.G * NWAVES;
        run_phase(C, ph);
        if (ph + 1 < args.ph_hi) xcd_barrier(xbar);
    }
}

extern "C" void kernel_launch(void* const* d_in, const int* in_sizes, int n_in, void* d_out, int out_size, void* d_ws, size_t ws_size, hipStream_t stream) {
    static int grid = 0;
    if (grid == 0) {
        if (n_in != 34 || ws_size < WS_END) { fprintf(stderr, "kernel_launch: n_in %d ws %zu (need %zu)\n", n_in, ws_size, (size_t)WS_END); grid = -1; return; }
        int dev = 0, cus = 0, per_cu = 0;
        hipGetDevice(&dev); hipDeviceGetAttribute(&cus, hipDeviceAttributeMultiprocessorCount, dev);
        hipFuncSetAttribute((const void*)mega_fwd, hipFuncAttributeMaxDynamicSharedMemorySize, LDS_BYTES);
        hipOccupancyMaxActiveBlocksPerMultiprocessor(&per_cu, (const void*)mega_fwd, NTHREADS, LDS_BYTES);
        if (per_cu < 1) per_cu = 1;
        grid = cus * 1;
        (void)hipGetLastError();
    }
    if (grid < 0) return;
    if (hipMemsetAsync((char*)d_ws + WS_BAR, 0, 16384, stream) != hipSuccess) { fprintf(stderr, "memset failed\n"); return; }
    Args a{};
    for (int i = 0; i < 34; ++i) a.in[i] = (const float*)d_in[i];
    a.out = (float*)d_out; a.ws = (unsigned char*)d_ws;
#if N_LAUNCH_MODE == 0
    a.ph_lo = 0; a.ph_hi = N_PHASES;
    void* kargs[] = {&a};
    hipError_t e = hipLaunchCooperativeKernel((const void*)mega_fwd, dim3(grid), dim3(NTHREADS), kargs, LDS_BYTES, stream);
    if (e != hipSuccess) fprintf(stderr, "cooperative launch failed: %s (grid %d)\n", hipGetErrorString(e), grid);
#else
    for (int ph = 0; ph < N_PHASES; ++ph) { a.ph_lo = ph; a.ph_hi = ph + 1; hipLaunchKernelGGL(mega_fwd, dim3(grid), dim3(NTHREADS), LDS_BYTES, stream, a); }
#endif
}
```
